# Optimizing an MI355X kernel written in HIP

```python
import math
import jax, jax.numpy as jnp
from jax import lax
import numpy as np


D_MODEL = 1024
BATCH = 2
SEQ = 8192
DEPTH = 2

HEAD_DIM = 128
BLOCK = 128
GRID_W = 64
EPS = 1e-6
NEG_INF = -1e30
RET_HEADS = D_MODEL // 256
RET_DK = 128
RET_DV = 256
RET_CHUNK = 128
RET_THETA = 10000.0
SWA_HEADS = D_MODEL // HEAD_DIM
SWA_KV_HEADS = 2
WINDOW = 128
T5_BUCKETS = 32
T5_MAX_DIST = 128
AX_HEADS = D_MODEL // HEAD_DIM
AX_KV_HEADS = 2
AX_THETA = 10000.0
D_FF = 4 * D_MODEL

N_EVEN = (DEPTH + 1) // 2
N_ODD = DEPTH // 2
RET_Q = RET_HEADS * RET_DK
RET_V = RET_HEADS * RET_DV
SWA_Q = SWA_HEADS * HEAD_DIM
SWA_KV = SWA_KV_HEADS * HEAD_DIM
EVEN_IN = 2 * RET_Q + 2 * RET_V + SWA_Q + 2 * SWA_KV
EVEN_OUT = RET_V + SWA_Q
AX_Q = AX_HEADS * HEAD_DIM
AX_KV = AX_KV_HEADS * HEAD_DIM
ODD_IN = AX_Q + 2 * AX_KV

kernel_name = "hybrid_retention_swa_axialrope_encoder"


def rms_norm(x, g):
    xf = x.astype(jnp.float32)
    y = xf * lax.rsqrt(jnp.mean(xf * xf, axis=-1, keepdims=True) + EPS)
    return (y * g.astype(jnp.float32)).astype(x.dtype)


def split_cols(a, sizes):
    offs, o = [], 0
    for s in sizes[:-1]:
        o += s
        offs.append(o)
    return jnp.split(a, offs, axis=-1)


def rope_angles(pos, dim, theta):
    inv = theta ** (-jnp.arange(0, dim, 2, dtype=jnp.float32) / dim)
    return pos.astype(jnp.float32)[:, None] * inv[None, :]


def apply_rope(x, ang):
    d2 = x.shape[-1] // 2
    xf = x.astype(jnp.float32)
    x1, x2 = xf[..., :d2], xf[..., d2:]
    c = jnp.cos(ang)[None, :, None, :]
    s = jnp.sin(ang)[None, :, None, :]
    return jnp.concatenate([x1 * c - x2 * s, x2 * c + x1 * s], axis=-1).astype(x.dtype)


def retention_direction(q, k, v, log_gamma, strict):
    Bn, S, H, dk = q.shape
    dv = v.shape[-1]
    C = RET_CHUNK
    nc = S // C
    qc = q.reshape(Bn, nc, C, H, dk)
    kc = k.reshape(Bn, nc, C, H, dk)
    vc = v.reshape(Bn, nc, C, H, dv)
    idx = jnp.arange(C, dtype=jnp.float32)
    diff = idx[:, None] - idx[None, :]
    mask = (diff > 0) if strict else (diff >= 0)
    decay = jnp.where(mask[None], jnp.exp(jnp.maximum(diff, 0.0)[None] * log_gamma[:, None, None]), 0.0)
    scores = jnp.einsum('bnrhd,bnjhd->bnhrj', qc, kc) * decay[None, None]
    inner = jnp.einsum('bnhrj,bnjhe->bnrhe', scores, vc)
    k_w = kc * jnp.exp((C - 1 - idx)[:, None] * log_gamma[None, :])[None, None, :, :, None]
    U = jnp.einsum('bnjhd,bnjhe->nbhde', k_w, vc)
    chunk_decay = jnp.exp(C * log_gamma)[None, :, None, None]

    def step(state, u):
        return chunk_decay * state + u, state

    _, prev = lax.scan(step, jnp.zeros((Bn, H, dk, dv), jnp.float32), U)
    q_w = qc * jnp.exp((idx + 1)[:, None] * log_gamma[None, :])[None, None, :, :, None]
    cross = jnp.einsum('bnrhd,nbhde->bnrhe', q_w, prev)
    return (inner + cross).reshape(Bn, S, H, dv)


def retention_mixer(q, k, v, g, decay_logit, gn_gain):
    Bn, S, _ = q.shape
    dt = v.dtype
    q = q.reshape(Bn, S, RET_HEADS, RET_DK)
    k = k.reshape(Bn, S, RET_HEADS, RET_DK)
    v = v.reshape(Bn, S, RET_HEADS, RET_DV).astype(jnp.float32)
    ang = rope_angles(jnp.arange(S), RET_DK, RET_THETA)
    q = apply_rope(q, ang).astype(jnp.float32)
    k = apply_rope(k, ang).astype(jnp.float32) * (RET_DK ** -0.5)
    log_gamma = jax.nn.log_sigmoid(decay_logit.astype(jnp.float32))
    fwd = retention_direction(q, k, v, log_gamma[0], False)
    bwd = jnp.flip(retention_direction(jnp.flip(q, 1), jnp.flip(k, 1), jnp.flip(v, 1),
                                       log_gamma[1], True), 1)
    y = rms_norm(fwd + bwd, gn_gain.reshape(RET_HEADS, RET_DV))
    y = y.reshape(Bn, S, RET_V).astype(dt)
    return jax.nn.silu(g) * y


def t5_bucket(rel):
    nb = T5_BUCKETS // 2
    max_exact = nb // 2
    ret = jnp.where(rel > 0, nb, 0)
    n = jnp.abs(rel)
    nf = jnp.maximum(n, 1).astype(jnp.float32)
    large = max_exact + (jnp.log(nf / max_exact) / math.log(T5_MAX_DIST / max_exact)
                         * (nb - max_exact)).astype(jnp.int32)
    large = jnp.minimum(large, nb - 1)
    return ret + jnp.where(n < max_exact, n, large)


def window_attention(q, k, v, sink, t5_table):
    Bn, S, Hq, D = q.shape
    Hkv = k.shape[2]
    G = Hq // Hkv
    nb = S // BLOCK
    pad = ((0, 0), (BLOCK, BLOCK), (0, 0), (0, 0))
    kp = jnp.pad(k, pad).reshape(Bn, nb + 2, BLOCK, Hkv, D)
    vp = jnp.pad(v, pad).reshape(Bn, nb + 2, BLOCK, Hkv, D)
    kw = jnp.concatenate([kp[:, :nb], kp[:, 1:nb + 1], kp[:, 2:]], axis=2)
    vw = jnp.concatenate([vp[:, :nb], vp[:, 1:nb + 1], vp[:, 2:]], axis=2)
    qb = q.reshape(Bn, nb, BLOCK, Hkv, G, D)
    s = jnp.einsum('bnqkgd,bnjkd->bnkgqj', qb, kw,
                   preferred_element_type=jnp.float32) * (D ** -0.5)
    r = jnp.arange(BLOCK)
    j = jnp.arange(3 * BLOCK)
    rel = j[None, :] - BLOCK - r[:, None]
    bias = t5_table.astype(jnp.float32)[t5_bucket(rel)]
    bias = bias.transpose(2, 0, 1).reshape(Hkv, G, BLOCK, 3 * BLOCK)
    kpos = (jnp.arange(nb)[:, None] - 1) * BLOCK + j[None, :]
    valid = (jnp.abs(rel) <= WINDOW)[None] & ((kpos >= 0) & (kpos < S))[:, None, :]
    s = jnp.where(valid[None, :, None, None], s + bias[None, None], NEG_INF)
    sink_l = sink.astype(jnp.float32).reshape(Hkv, G)[None, None, :, :, None, None]
    m = jnp.maximum(jnp.max(s, axis=-1, keepdims=True), sink_l)
    p = jnp.exp(s - m)
    p = p / (jnp.sum(p, axis=-1, keepdims=True) + jnp.exp(sink_l - m))
    o = jnp.einsum('bnkgqj,bnjkd->bnqkgd', p.astype(v.dtype), vw)
    return o.reshape(Bn, S, Hq * D)


def axial_attention(q, k, v):
    Bn, S, Hq, D = q.shape
    Hkv = k.shape[2]
    G = Hq // Hkv
    rows = S // GRID_W
    row = jnp.repeat(jnp.arange(rows), GRID_W)
    col = jnp.tile(jnp.arange(GRID_W), rows)
    half = D // 2
    ang_r = rope_angles(row, half, AX_THETA)
    ang_c = rope_angles(col, half, AX_THETA)
    q = jnp.concatenate([apply_rope(q[..., :half], ang_r), apply_rope(q[..., half:], ang_c)], axis=-1)
    k = jnp.concatenate([apply_rope(k[..., :half], ang_r), apply_rope(k[..., half:], ang_c)], axis=-1)
    nb = S // BLOCK
    qb = q.reshape(Bn, nb, BLOCK, Hkv, G, D).transpose(1, 0, 2, 3, 4, 5)
    scale = D ** -0.5

    def block(qi):
        s = jnp.einsum('bqkgd,bjkd->bkgqj', qi, k, preferred_element_type=jnp.float32) * scale
        p = jax.nn.softmax(s, axis=-1)
        return jnp.einsum('bkgqj,bjkd->bqkgd', p.astype(v.dtype), v)

    o = lax.map(block, qb)
    return o.transpose(1, 0, 2, 3, 4, 5).reshape(Bn, S, Hq * D)


def setup_inputs(seed: int = 0) -> dict:
    key = jax.random.key(seed)
    ks = jax.random.split(key, 20)
    f32 = jnp.float32

    def w(k, shape, fan_in):
        return jax.random.normal(k, shape, f32) * (fan_in ** -0.5)

    def gain(k, shape):
        return 1.0 + 0.05 * jax.random.normal(k, shape, f32)

    base_logit = jnp.log(2.0 ** (5.0 + jnp.arange(RET_HEADS, dtype=f32)) - 1.0)
    return {
        'x': jax.random.normal(ks[0], (BATCH, SEQ, D_MODEL), f32),
        'norm_mix': gain(ks[1], (DEPTH, D_MODEL)),
        'norm_mlp': gain(ks[2], (DEPTH, D_MODEL)),
        'w_in_even': w(ks[3], (N_EVEN, D_MODEL, EVEN_IN), D_MODEL),
        'w_out_even': w(ks[4], (N_EVEN, EVEN_OUT, D_MODEL), EVEN_OUT),
        'ret_decay_logit': base_logit[None, None, :] + 0.1 * jax.random.normal(ks[5], (N_EVEN, 2, RET_HEADS), f32),
        'ret_norm': gain(ks[6], (N_EVEN, RET_V)),
        'swa_q_norm': gain(ks[7], (N_EVEN, HEAD_DIM)),
        'swa_k_norm': gain(ks[8], (N_EVEN, HEAD_DIM)),
        'swa_sink': 0.5 * jax.random.normal(ks[9], (N_EVEN, SWA_HEADS), f32),
        't5_table': 0.5 * jax.random.normal(ks[10], (T5_BUCKETS, SWA_HEADS), f32),
        'w_in_odd': w(ks[11], (N_ODD, D_MODEL, ODD_IN), D_MODEL),
        'w_out_odd': w(ks[12], (N_ODD, AX_Q, D_MODEL), AX_Q),
        'ax_q_norm': gain(ks[13], (N_ODD, HEAD_DIM)),
        'ax_k_norm': gain(ks[14], (N_ODD, HEAD_DIM)),
        'w_mlp_up': w(ks[15], (DEPTH, D_MODEL, D_FF), D_MODEL),
        'w_mlp_down': w(ks[16], (DEPTH, D_FF, D_MODEL), D_FF),
    }


def reference(x, norm_mix, norm_mlp, w_in_even, w_out_even, ret_decay_logit, ret_norm,
              swa_q_norm, swa_k_norm, swa_sink, t5_table, w_in_odd, w_out_odd,
              ax_q_norm, ax_k_norm, w_mlp_up, w_mlp_down):
    Bn, S, _ = x.shape
    for layer in range(DEPTH):
        h = rms_norm(x, norm_mix[layer])
        if layer % 2 == 0:
            i = layer // 2
            proj = h @ w_in_even[i]
            qa, ka, va, ga, qb, kb, vb = split_cols(
                proj, [RET_Q, RET_Q, RET_V, RET_V, SWA_Q, SWA_KV, SWA_KV])
            ya = retention_mixer(qa, ka, va, ga, ret_decay_logit[i], ret_norm[i])
            qb = rms_norm(qb.reshape(Bn, S, SWA_HEADS, HEAD_DIM), swa_q_norm[i])
            kb = rms_norm(kb.reshape(Bn, S, SWA_KV_HEADS, HEAD_DIM), swa_k_norm[i])
            vb = vb.reshape(Bn, S, SWA_KV_HEADS, HEAD_DIM)
            yb = window_attention(qb, kb, vb, swa_sink[i], t5_table)
            y = jnp.concatenate([ya, yb], axis=-1) @ w_out_even[i]
        else:
            i = layer // 2
            proj = h @ w_in_odd[i]
            qc, kc, vc = split_cols(proj, [AX_Q, AX_KV, AX_KV])
            qc = rms_norm(qc.reshape(Bn, S, AX_HEADS, HEAD_DIM), ax_q_norm[i])
            kc = rms_norm(kc.reshape(Bn, S, AX_KV_HEADS, HEAD_DIM), ax_k_norm[i])
            vc = vc.reshape(Bn, S, AX_KV_HEADS, HEAD_DIM)
            y = axial_attention(qc, kc, vc) @ w_out_odd[i]
        x = x + y
        h = rms_norm(x, norm_mlp[layer])
        x = x + jnp.square(jax.nn.relu(h @ w_mlp_up[layer])) @ w_mlp_down[layer]
    return x
```

```cpp
#include <hip/hip_runtime.h>
#include <hip/hip_bf16.h>
#include <cstdio>
#include <cstdint>
#include <cmath>
__device__ __forceinline__ int lane_id_v() { int l; asm volatile("v_mbcnt_lo_u32_b32 %0, -1, 0\n\tv_mbcnt_hi_u32_b32 %0, -1, %0" : "=v"(l)); return l; }
__device__ __forceinline__ bool is_t0(int wave) { return wave == 0 && lane_id_v() == 0; }
namespace pg8 {
#define PG8_LAS __attribute__((address_space(3)))
typedef unsigned short bf16_t;
typedef short bf16x8 __attribute__((ext_vector_type(8)));
typedef float f32x4 __attribute__((ext_vector_type(4)));
typedef unsigned u32x4 __attribute__((ext_vector_type(4)));
typedef unsigned u32x2 __attribute__((ext_vector_type(2)));
constexpr int BM = 256, BK = 64, HALF = 128, HTB = HALF * BK * 2  , STAGE_BYTES = 8 * HTB, NXCD = 8, WGM = 8;

__host__ __device__ __forceinline__ int lds_byte(int r, int c) { const int st = (r >> 4) * 2 + (c >> 5), rr = r & 15, cc = c & 31, ob = rr * 64 + cc * 2; return st * 1024 + (ob ^ (((ob >> 9) & 1) << 5)); }
__host__ __device__ __forceinline__ void stage_rc(int b, int& R, int& C) { const int st = b / 1024, sb = b % 1024, swz = sb ^ (((sb >> 9) & 1) << 5); R = (st >> 1) * 16 + swz / 64; C = (st & 1) * 32 + (swz % 64) / 2; }
__host__ __device__ __forceinline__ int perm32(int rho) { const int n = rho >> 4, i = rho & 15; return 8 * (i >> 2) + 4 * n + (i & 3); }

struct Unit { int pm, pn; };
struct Gemm { const bf16_t* A; const bf16_t* Bt; int M, N, K, lda; };

struct StaticOrder {
    int nM, nN, nwg, G, c;
    __host__ __device__ void init(int M, int N, int G_, int c_) { nM = M / BM; nN = N / BM; nwg = nM * nN; G = G_; c = c_; }
    __host__ __device__ bool next(int i, Unit& u) const {
        const long L = (long)i * G + c; if (L >= nwg) return false;
        int wgid = (int)L; { const int q = nwg / NXCD, r = nwg % NXCD, xcd = wgid % NXCD, off = wgid / NXCD; wgid = (xcd < r ? xcd * (q + 1) : r * (q + 1) + (xcd - r) * q) + off; }
        const int nig = WGM * nN, gid = wgid / nig, fm = gid * WGM, gsz = (nM - fm) < WGM ? (nM - fm) : WGM;
        u.pm = fm + ((wgid % nig) % gsz); u.pn = (wgid % nig) / gsz; return true;
    }
    __device__ __forceinline__ void a_ready(const Unit&) const {}
    __device__ __forceinline__ void done(const Unit&) const {}
};

__device__ __forceinline__ unsigned cvt_pk_bf16(float lo, float hi) { unsigned r; asm volatile("v_cvt_pk_bf16_f32 %0, %1, %2" : "=v"(r) : "v"(lo), "v"(hi)); return r; }
constexpr float RMS_EPS = 1e-6f;
__device__ __forceinline__ float row_rs(const float* part, int row) {
    const f32x4* p = (const f32x4*)(part + (size_t)row * 16);
    const f32x4 a = p[0], b = p[1], c = p[2], d = p[3];
    const float s = ((a[0] + a[1]) + (a[2] + a[3])) + ((b[0] + b[1]) + (b[2] + b[3])) + ((c[0] + c[1]) + (c[2] + c[3])) + ((d[0] + d[1]) + (d[2] + d[3]));
    return __builtin_amdgcn_rsqf(s * (1.0f / 1024.0f) + RMS_EPS);
}
template <int ACT> struct EpiBf {
    static constexpr bool PERM = true, AFTER_DRAIN = false;
    bf16_t* O; int ldc; const float* part;
    __device__ __forceinline__ void operator()(const f32x4 (&acc)[2][2][4][2], const Unit& u, int wr, int wc, int fr, int fq) const {
        const int row0 = u.pm * BM + wr * 64 + fr, col0 = u.pn * BM + wc * 32 + 8 * fq;
#pragma unroll
        for (int ai = 0; ai < 2; ++ai)
#pragma unroll
            for (int m = 0; m < 4; ++m) { const int row = row0 + ai * HALF + m * 16; bf16_t* rowp = O + (size_t)row * ldc + col0;
                const float sc = part ? row_rs(part, row) : 1.0f;
#pragma unroll
                for (int bj = 0; bj < 2; ++bj) { f32x4 v0 = acc[ai][bj][m][0] * sc, v1 = acc[ai][bj][m][1] * sc;
                    if (ACT == 2) {
#pragma unroll
                        for (int e = 0; e < 4; ++e) { const float a = fmaxf(v0[e], 0.f), b = fmaxf(v1[e], 0.f); v0[e] = a * a; v1[e] = b * b; } }
                    u32x4 w; w.x = cvt_pk_bf16(v0[0], v0[1]); w.y = cvt_pk_bf16(v0[2], v0[3]); w.z = cvt_pk_bf16(v1[0], v1[1]); w.w = cvt_pk_bf16(v1[2], v1[3]);
                    *(u32x4*)(rowp + bj * HALF) = w; } }
    }
};
template <int MODE> struct EpiRes {
    static constexpr bool PERM = false, AFTER_DRAIN = false;
    const float* basef; const bf16_t* baseb; const float* gprev; float* outf; bf16_t* xn; const float* g; float* part; const float* part_in;
    __device__ __forceinline__ void operator()(const f32x4 (&acc)[2][2][4][2], const Unit& u, int wr, int wc, int fr, int fq) const {
        const int row0 = u.pm * BM + wr * 64 + fr, col0 = u.pn * BM + wc * 32 + 4 * fq;
        f32x4 gv[2][2], gi[2][2];
#pragma unroll
        for (int bj = 0; bj < 2; ++bj)
#pragma unroll
            for (int n = 0; n < 2; ++n) {
                if (MODE != 2) gv[bj][n] = *(const f32x4*)(g + col0 + bj * HALF + n * 16);
                if (MODE != 0) { const f32x4 t = *(const f32x4*)(gprev + col0 + bj * HALF + n * 16); gi[bj][n] = (f32x4){1.0f / t[0], 1.0f / t[1], 1.0f / t[2], 1.0f / t[3]}; } }
#pragma unroll
        for (int ai = 0; ai < 2; ++ai)
#pragma unroll
            for (int m = 0; m < 4; ++m) { const int row = row0 + ai * HALF + m * 16; const size_t off = (size_t)row * 1024 + col0; float s = 0.f;
                float sc2 = 1.0f; if (part_in) { const float r_ = row_rs(part_in, row); sc2 = r_ * r_; }
#pragma unroll
                for (int bj = 0; bj < 2; ++bj)
#pragma unroll
                    for (int n = 0; n < 2; ++n) { const size_t o2 = off + bj * HALF + n * 16; f32x4 b;
                        if (MODE == 0) b = *(const f32x4*)(basef + o2);
                        else { const u32x2 w = *(const u32x2*)(baseb + o2);
                            b = (f32x4){__uint_as_float(w.x << 16), __uint_as_float(w.x & 0xffff0000u), __uint_as_float(w.y << 16), __uint_as_float(w.y & 0xffff0000u)} * gi[bj][n]; }
                        const f32x4 o = b + acc[ai][bj][m][n] * sc2;
                        if (MODE == 2) *(f32x4*)(outf + o2) = o;
                        else { s += (o[0] * o[0] + o[1] * o[1]) + (o[2] * o[2] + o[3] * o[3]); const f32x4 t = o * gv[bj][n];
                            u32x2 w; w.x = cvt_pk_bf16(t[0], t[1]); w.y = cvt_pk_bf16(t[2], t[3]); *(u32x2*)(xn + o2) = w; } }
                if (MODE != 2) { s += __shfl_xor(s, 16); s += __shfl_xor(s, 32); if (fq == 0) part[(size_t)row * 16 + u.pn * 4 + wc] = s; }
                if (m & 1) asm volatile("" ::: "memory"); }
    }
};
struct EpiProj {
    static constexpr bool PERM = true, AFTER_DRAIN = false;
    bf16_t* O; int ldc; const float* part; PG8_LAS float* xs; int layer; const float* gq; const float* gk; unsigned char* q8; unsigned char* k8; unsigned char* v8t;
    __device__ __forceinline__ void operator()(const f32x4 (&acc)[2][2][4][2], const Unit& u, int wr, int wc, int fr, int fq) const {
        const int pn = u.pn; int kind; const float* g;
        if (layer == 0) { kind = pn < 2 ? 1 : pn < 4 ? 2 : pn < 8 ? 0 : pn < 12 ? 3 : pn < 17 ? 4 : 0; g = pn < 16 ? gq : gk; }
        else { kind = pn < 5 ? 5 : 0; g = pn < 4 ? gq : gk; }
        const int row0 = u.pm * BM + wr * 64 + fr;
        const int head = wc >> 1, sub = wc & 1;
        int c0, c1, d0;
        if (kind == 0 || kind == 3) { c0 = wc * 32 + 8 * fq; c1 = c0 + HALF; d0 = 0; }
        else if (kind == 5) { d0 = 64 * sub + 8 * fq; c0 = 128 * head + d0; c1 = c0 + 32; }
        else { d0 = 32 * sub + 8 * fq; c0 = 128 * head + d0; c1 = c0 + 64; }
        const int dpair = (kind == 5) ? 32 : 64;
        f32x4 v[2][4][2][2];
#pragma unroll
        for (int ai = 0; ai < 2; ++ai)
#pragma unroll
            for (int m = 0; m < 4; ++m) { const float sc = part ? row_rs(part, row0 + ai * HALF + m * 16) : 1.0f;
#pragma unroll
                for (int bj = 0; bj < 2; ++bj)
#pragma unroll
                    for (int n = 0; n < 2; ++n) v[ai][m][bj][n] = acc[ai][bj][m][n] * sc; }
        if (kind >= 4) {
#pragma unroll
            for (int ai = 0; ai < 2; ++ai)
#pragma unroll
                for (int m = 0; m < 4; ++m) { float s = 0.f;
#pragma unroll
                    for (int bj = 0; bj < 2; ++bj)
#pragma unroll
                        for (int n = 0; n < 2; ++n) { const f32x4 x = v[ai][m][bj][n]; s += (x[0] * x[0] + x[1] * x[1]) + (x[2] * x[2] + x[3] * x[3]); }
                    s += __shfl_xor(s, 16); s += __shfl_xor(s, 32);
                    if (fq == 0) xs[(wr * 4 + wc) * 128 + (ai * 4 + m) * 16 + fr] = s; }
            asm volatile("s_waitcnt lgkmcnt(0)" ::: "memory"); __builtin_amdgcn_s_barrier(); asm volatile("" ::: "memory");
            f32x4 gv[2][2];
#pragma unroll
            for (int bj = 0; bj < 2; ++bj)
#pragma unroll
                for (int n = 0; n < 2; ++n) gv[bj][n] = *(const f32x4*)(g + d0 + bj * dpair + 4 * n);
#pragma unroll
            for (int ai = 0; ai < 2; ++ai)
#pragma unroll
                for (int m = 0; m < 4; ++m) { const int xi = (ai * 4 + m) * 16 + fr; const float tot = xs[(wr * 4 + wc) * 128 + xi] + xs[(wr * 4 + (wc ^ 1)) * 128 + xi];
                    const float rn = 1.0f / sqrtf(tot * (1.0f / 128.0f) + RMS_EPS);
#pragma unroll
                    for (int bj = 0; bj < 2; ++bj)
#pragma unroll
                        for (int n = 0; n < 2; ++n) v[ai][m][bj][n] = v[ai][m][bj][n] * rn * gv[bj][n]; }
        }
        if (kind == 1 || kind == 2 || kind == 5) {
            const float fstep = (kind == 5) ? (13.287712379549449f / 32.0f) : (13.287712379549449f / 64.0f);
            const int f0 = (kind == 5) ? 8 * fq : d0;
            float inv[8];
#pragma unroll
            for (int k = 0; k < 8; ++k) inv[k] = exp2f(-(float)(f0 + k) * fstep);
            const float osc = (kind == 2) ? 0.08838834764831845f : (kind == 5 && pn < 4) ? (0.08838834764831845f * 1.4426950408889634f) : 1.0f;
#pragma unroll
            for (int ai = 0; ai < 2; ++ai)
#pragma unroll
                for (int m = 0; m < 4; ++m) { const int t = (row0 + ai * HALF + m * 16) & 8191; const float pos = (float)((kind == 5) ? (sub ? (t & 63) : (t >> 6)) : t);
#pragma unroll
                    for (int n = 0; n < 2; ++n)
#pragma unroll
                        for (int i = 0; i < 4; ++i) { float rev = (pos * inv[4 * n + i]) * 0.15915494309189535f; rev -= rintf(rev);
                            const float sn = __builtin_amdgcn_sinf(rev), cs = __builtin_amdgcn_cosf(rev);
                            const float x1 = v[ai][m][0][n][i], x2 = v[ai][m][1][n][i];
                            v[ai][m][0][n][i] = (x1 * cs - x2 * sn) * osc; v[ai][m][1][n][i] = (x2 * cs + x1 * sn) * osc; } }
        }
        if (kind == 3) {
#pragma unroll
            for (int ai = 0; ai < 2; ++ai)
#pragma unroll
                for (int m = 0; m < 4; ++m)
#pragma unroll
                    for (int bj = 0; bj < 2; ++bj)
#pragma unroll
                        for (int n = 0; n < 2; ++n)
#pragma unroll
                            for (int i = 0; i < 4; ++i) { const float x = v[ai][m][bj][n][i]; v[ai][m][bj][n][i] = x * __builtin_amdgcn_rcpf(1.0f + __builtin_amdgcn_exp2f(-1.4426950408889634f * x)); }
        }
        if (layer == 1 && pn == 5 && v8t) {
            const int d0v = wc * 32 + 8 * fq, hv = (fr >> 2) & 1, odd = fr & 1;
#pragma unroll
            for (int ai = 0; ai < 2; ++ai)
#pragma unroll
                for (int m = 0; m < 4; ++m) { const int row = row0 + ai * HALF + m * 16; const int tile = (row & 8191) >> 6, bb = row >> 13;
                    const int jv = 16 * (m >> 1) + 8 * (m & 1) + 4 * (fr >> 3) + (fr & 2);
#pragma unroll
                    for (int bj = 0; bj < 2; ++bj) { float x[8], y[8];
#pragma unroll
                        for (int e = 0; e < 4; ++e) { x[e] = v[ai][m][bj][0][e]; x[4 + e] = v[ai][m][bj][1][e]; }
#pragma unroll
                        for (int e = 0; e < 8; ++e) y[e] = __shfl_xor(x[e], 1);
                        unsigned char* blk = v8t + ((size_t)((bb * 2 + bj) * 128 + tile) * 128 + d0v + 4 * odd) * 64 + hv * 32 + jv;
#pragma unroll
                        for (int e = 0; e < 4; ++e) { const float lo = odd ? y[4 + e] : x[e], hi_ = odd ? x[4 + e] : y[e];
                            const int w = __builtin_amdgcn_cvt_pk_fp8_f32(lo, hi_, 0, false); *(unsigned short*)(blk + e * 64) = (unsigned short)(w & 0xffff); } } }
        }
        if (kind == 5 && q8) {
            const float f8s = 1.0f; unsigned char* b8 = (pn < 4) ? q8 + (size_t)pn * BM : k8; const int ld8 = (pn < 4) ? 1024 : 256;
#pragma unroll
            for (int ai = 0; ai < 2; ++ai)
#pragma unroll
                for (int m = 0; m < 4; ++m) { unsigned char* rp = b8 + (size_t)(row0 + ai * HALF + m * 16) * ld8;
#pragma unroll
                    for (int bj = 0; bj < 2; ++bj) { const f32x4 a0 = v[ai][m][bj][0] * f8s, a1 = v[ai][m][bj][1] * f8s;
                        int w0 = __builtin_amdgcn_cvt_pk_fp8_f32(a0[0], a0[1], 0, false); w0 = __builtin_amdgcn_cvt_pk_fp8_f32(a0[2], a0[3], w0, true);
                        int w1 = __builtin_amdgcn_cvt_pk_fp8_f32(a1[0], a1[1], 0, false); w1 = __builtin_amdgcn_cvt_pk_fp8_f32(a1[2], a1[3], w1, true);
                        u32x2 w; w.x = (unsigned)w0; w.y = (unsigned)w1; *(u32x2*)(rp + (bj ? c1 : c0)) = w; } }
        }
#pragma unroll
        for (int ai = 0; ai < 2; ++ai)
#pragma unroll
            for (int m = 0; m < 4; ++m) { bf16_t* rowp = O + (size_t)(row0 + ai * HALF + m * 16) * ldc + pn * BM;
#pragma unroll
                for (int bj = 0; bj < 2; ++bj) { const f32x4 v0 = v[ai][m][bj][0], v1 = v[ai][m][bj][1];
                    u32x4 w; w.x = cvt_pk_bf16(v0[0], v0[1]); w.y = cvt_pk_bf16(v0[2], v0[3]); w.z = cvt_pk_bf16(v1[0], v1[1]); w.w = cvt_pk_bf16(v1[2], v1[3]);
                    *(u32x4*)(rowp + (bj ? c1 : c0)) = w; } }
    }
};

template <class Epi, class Sched, bool ALIGN_EPI = false, bool SP2 = false>
__device__ __forceinline__ void gemm_phase(PG8_LAS unsigned char* lds, const Gemm g, const Sched& S, const Epi& E, const int wave_s) {
    int tid_ = wave_s * 64 + lane_id_v();
    const int tid = tid_, wid = wave_s, lane = tid & 63, wr = wid >> 2, wc = wid & 3, fr = lane & 15, fq = lane >> 4;
    const int K = g.K, nt = K / BK;
    unsigned voffA[2], voffB[2];
#pragma unroll
    for (int i = 0; i < 2; ++i) { int R, C; stage_rc(tid * 16 + i * 8192, R, C); const int Rb = Epi::PERM ? ((R & ~31) + perm32(R & 31)) : R;
        voffA[i] = (unsigned)(R * g.lda + C) * 2u; voffB[i] = (unsigned)(Rb * K + C) * 2u; }
    const size_t kstep = (size_t)(BK * 2);
    const size_t hstep = (size_t)HALF * K * 2, hstepA = (size_t)HALF * g.lda * 2;
    const size_t tstep = 2 * hstep, tstepA = 2 * hstepA;
    const unsigned ldsw = (unsigned)wid * 1024u;
    const int aoff = lds_byte(wr * 64 + fr, fq * 8), boff = lds_byte(wc * 32 + fr, fq * 8);
#define PG8_SA(b, h) (((b) * 2 + (h)) * HTB)
#define PG8_SB(b, h) ((4 + (b) * 2 + (h)) * HTB)
#define PG8_STAGE(bufoff, gbase, voff) do { _Pragma("unroll") for (int _i = 0; _i < 2; ++_i) \
        __builtin_amdgcn_global_load_lds((const unsigned*)((const char*)(gbase) + (voff)[_i]), (PG8_LAS unsigned*)(lds + (bufoff) + ldsw + _i * 8192), 16, 0, 0); } while (0)
#define PG8_LDA(dst, b, h) do { _Pragma("unroll") for (int m = 0; m < 4; ++m) _Pragma("unroll") for (int k = 0; k < 2; ++k) dst[m][k] = *(const PG8_LAS bf16x8*)(lds + PG8_SA(b, h) + aoff + m * 2048 + k * 1024); } while (0)
#define PG8_LDB(dst, b, h) do { _Pragma("unroll") for (int n = 0; n < 2; ++n) _Pragma("unroll") for (int k = 0; k < 2; ++k) dst[n][k] = *(const PG8_LAS bf16x8*)(lds + PG8_SB(b, h) + boff + n * 2048 + k * 1024); } while (0)
#define PG8_MMA(ai, bj, At, Bt) do { __builtin_amdgcn_s_setprio(1); _Pragma("unroll") for (int m = 0; m < 4; ++m) _Pragma("unroll") for (int n = 0; n < 2; ++n) _Pragma("unroll") for (int k = 0; k < 2; ++k) \
        acc[ai][bj][m][n] = __builtin_amdgcn_mfma_f32_16x16x32_bf16(Bt[n][k], At[m][k], acc[ai][bj][m][n], 0, 0, 0); __builtin_amdgcn_s_setprio(0); } while (0)
#define PG8_WAIT_V(n) asm volatile("s_waitcnt vmcnt(" #n ")" ::: "memory")
#define PG8_WAIT_L(n) asm volatile("s_waitcnt lgkmcnt(" #n ")" ::: "memory")
#define PG8_BAR __builtin_amdgcn_s_barrier()
#define PG8_SCHED __builtin_amdgcn_sched_barrier(0)
    Unit cur, nxt; int ui = 0;
    if (!S.next(0, cur)) return;
    f32x4 acc[2][2][4][2];
#pragma unroll
    for (int a = 0; a < 2; ++a)
#pragma unroll
        for (int b = 0; b < 2; ++b)
#pragma unroll
            for (int m = 0; m < 4; ++m)
#pragma unroll
                for (int n = 0; n < 2; ++n) acc[a][b][m][n] = (f32x4){0.f, 0.f, 0.f, 0.f};
    bf16x8 At[4][2], B0[2][2], B1[2][2];
    const char* cA = (const char*)g.A + (size_t)cur.pm * tstepA; const char* cB = (const char*)g.Bt + (size_t)cur.pn * tstep;
    S.a_ready(cur);
    if constexpr (SP2) {
        PG8_STAGE(PG8_SB(0, 0), cB, voffB); PG8_STAGE(PG8_SB(0, 1), cB + hstep, voffB); PG8_STAGE(PG8_SA(0, 0), cA, voffA); PG8_STAGE(PG8_SA(0, 1), cA + hstepA, voffA);
        if (wr == 1) PG8_BAR;
        PG8_WAIT_V(2); PG8_BAR;
        PG8_STAGE(PG8_SB(1, 0), cB + kstep, voffB); PG8_STAGE(PG8_SA(1, 0), cA + kstep, voffA); PG8_STAGE(PG8_SB(1, 1), cB + hstep + kstep, voffB);
        PG8_WAIT_V(6); PG8_BAR;
    } else {
        PG8_STAGE(PG8_SB(0, 0), cB, voffB); PG8_STAGE(PG8_SA(0, 0), cA, voffA); PG8_STAGE(PG8_SB(0, 1), cB + hstep, voffB); PG8_STAGE(PG8_SA(0, 1), cA + hstepA, voffA);
        if (wr == 1) PG8_BAR;
        PG8_WAIT_V(4); PG8_BAR;
        PG8_STAGE(PG8_SB(1, 0), cB + kstep, voffB); PG8_STAGE(PG8_SA(1, 0), cA + kstep, voffA); PG8_STAGE(PG8_SB(1, 1), cB + hstep + kstep, voffB);
        PG8_WAIT_V(6); PG8_BAR;
    }
    for (;;) {
        const bool has_next = S.next(ui + 1, nxt);
        const char* nA = has_next ? (const char*)g.A + (size_t)nxt.pm * tstepA : cA; const char* nB = has_next ? (const char*)g.Bt + (size_t)nxt.pn * tstep : cB;
        for (int t = 0; t < nt; t += 2) {
            const bool last = (t == nt - 2);
            const char* a1 = cA + (size_t)(t + 1) * kstep;
            const char* a2 = last ? nA : cA + (size_t)(t + 2) * kstep; const char* b2 = last ? nB : cB + (size_t)(t + 2) * kstep;
            const char* a3 = a2 + kstep; const char* b3 = b2 + kstep;
            if (last && has_next) S.a_ready(nxt);
            if constexpr (SP2) {
            PG8_LDB(B0, 0, 0); PG8_LDB(B1, 0, 1); PG8_SCHED; PG8_LDA(At, 0, 0); PG8_STAGE(PG8_SA(1, 1), a1 + hstepA, voffA);
            PG8_WAIT_V(8); PG8_WAIT_L(0); PG8_BAR; PG8_MMA(0, 0, At, B0); PG8_MMA(0, 1, At, B1); PG8_BAR; PG8_SCHED;
            PG8_LDA(At, 0, 1); PG8_STAGE(PG8_SB(0, 0), b2, voffB); PG8_STAGE(PG8_SB(0, 1), b2 + hstep, voffB); PG8_STAGE(PG8_SA(0, 0), a2, voffA);
            PG8_WAIT_V(8); PG8_WAIT_L(0); PG8_BAR; PG8_MMA(1, 0, At, B0); PG8_MMA(1, 1, At, B1); PG8_BAR; PG8_SCHED;
            PG8_LDB(B0, 1, 0); PG8_LDB(B1, 1, 1); PG8_SCHED; PG8_LDA(At, 1, 0); PG8_STAGE(PG8_SA(0, 1), a2 + hstepA, voffA);
            PG8_WAIT_V(8); PG8_WAIT_L(0); PG8_BAR; PG8_MMA(0, 0, At, B0); PG8_MMA(0, 1, At, B1); PG8_BAR; PG8_SCHED;
            PG8_LDA(At, 1, 1); PG8_STAGE(PG8_SB(1, 0), b3, voffB); PG8_STAGE(PG8_SB(1, 1), b3 + hstep, voffB); PG8_STAGE(PG8_SA(1, 0), a3, voffA);
            PG8_WAIT_V(8); PG8_WAIT_L(0); PG8_BAR; PG8_MMA(1, 0, At, B0); PG8_MMA(1, 1, At, B1); PG8_BAR; PG8_SCHED;
            } else {
            PG8_LDB(B0, 0, 0); PG8_SCHED; PG8_LDA(At, 0, 0); PG8_STAGE(PG8_SA(1, 1), a1 + hstepA, voffA);
            PG8_WAIT_L(8); PG8_BAR; PG8_WAIT_L(0); PG8_MMA(0, 0, At, B0); PG8_BAR; PG8_SCHED;
            PG8_LDB(B1, 0, 1); PG8_STAGE(PG8_SB(0, 0), b2, voffB);
            PG8_BAR; PG8_WAIT_L(0); PG8_MMA(0, 1, At, B1); PG8_BAR;
            PG8_LDA(At, 0, 1); PG8_STAGE(PG8_SA(0, 0), a2, voffA);
            PG8_BAR; PG8_WAIT_L(0); PG8_MMA(1, 0, At, B0); PG8_BAR; PG8_SCHED;
            PG8_STAGE(PG8_SB(0, 1), b2 + hstep, voffB);
            PG8_WAIT_V(6); PG8_BAR; PG8_MMA(1, 1, At, B1); PG8_BAR;
            PG8_LDB(B0, 1, 0); PG8_SCHED; PG8_LDA(At, 1, 0); PG8_STAGE(PG8_SA(0, 1), a2 + hstepA, voffA);
            PG8_WAIT_L(8); PG8_BAR; PG8_WAIT_L(0); PG8_MMA(0, 0, At, B0); PG8_BAR; PG8_SCHED;
            PG8_LDB(B1, 1, 1); PG8_STAGE(PG8_SB(1, 0), b3, voffB);
            PG8_BAR; PG8_WAIT_L(0); PG8_MMA(0, 1, At, B1); PG8_BAR;
            PG8_LDA(At, 1, 1); PG8_STAGE(PG8_SA(1, 0), a3, voffA);
            PG8_BAR; PG8_WAIT_L(0); PG8_MMA(1, 0, At, B0); PG8_BAR; PG8_SCHED;
            PG8_STAGE(PG8_SB(1, 1), b3 + hstep, voffB);
            PG8_WAIT_V(6); PG8_BAR; PG8_MMA(1, 1, At, B1); PG8_BAR;
            }
        }
        if constexpr (ALIGN_EPI) { if (wr == 0) PG8_BAR; }
        if constexpr (!Epi::AFTER_DRAIN) { E(acc, cur, wr, wc, fr, fq); S.done(cur); }
        if (!has_next) break;
#pragma unroll
        for (int a = 0; a < 2; ++a)
#pragma unroll
            for (int b = 0; b < 2; ++b)
#pragma unroll
                for (int m = 0; m < 4; ++m)
#pragma unroll
                    for (int n = 0; n < 2; ++n) acc[a][b][m][n] = (f32x4){0.f, 0.f, 0.f, 0.f};
        cur = nxt; cA = nA; cB = nB; ++ui;
        if constexpr (ALIGN_EPI) { if (wr == 1) PG8_BAR; }
    }
    PG8_WAIT_V(0);
    if constexpr (!ALIGN_EPI) { if (wr == 0) PG8_BAR; }
    PG8_BAR;
    if constexpr (Epi::AFTER_DRAIN) { E.fused(acc, cur, wr, wc, fr, fq, lds, wid, lane); S.done(cur); }
#undef PG8_SA
#undef PG8_SB
#undef PG8_STAGE
#undef PG8_LDA
#undef PG8_LDB
#undef PG8_MMA
#undef PG8_WAIT_V
#undef PG8_WAIT_L
#undef PG8_BAR
#undef PG8_SCHED
}
}
namespace adense {
using bf16 = __hip_bfloat16;
constexpr int D = 128, NW = 8, QBLK = 32, KVBLK = 64;
constexpr float SCALE = 0.088388347648318440f;
constexpr float THR = 8.f;
constexpr size_t SHM_V = KVBLK * D * 2, SHM_K = KVBLK * D * 2, SHM_ATTN = 2 * SHM_V + 2 * SHM_K + NW * 64 * 4;
using bf16x8 = __attribute__((ext_vector_type(8))) short;
using s16x4  = __attribute__((ext_vector_type(4))) short;
using f32x16 = __attribute__((ext_vector_type(16))) float;
using u32x4  = __attribute__((ext_vector_type(4))) unsigned;
#define KSWZ(row, colB) ((row) * 256 + ((colB) ^ ((((row) & 7) | ((((row) >> 4) & 1) << 3)) << 4)))
#define SBAR() __builtin_amdgcn_sched_barrier(0)
__device__ __forceinline__ int crow(int r, int hi) { return (r & 3) + 8 * (r >> 2) + 4 * hi; }
__device__ __forceinline__ unsigned cvtpk(float lo, float hi) { unsigned r; asm volatile("v_cvt_pk_bf16_f32 %0, %1, %2" : "=v"(r) : "v"(lo), "v"(hi)); return r; }
__device__ __forceinline__ bf16x8 ld8(const bf16* p) { return *reinterpret_cast<const bf16x8*>(p); }
typedef float f32x2_t __attribute__((ext_vector_type(2))); typedef __bf16 bf16x2_t __attribute__((ext_vector_type(2)));
__device__ __forceinline__ unsigned cvtpk_m(float lo, float hi) { f32x2_t v = {lo, hi}; bf16x2_t b = __builtin_convertvector(v, bf16x2_t); return __builtin_bit_cast(unsigned, b); }

__device__ __forceinline__ void partialSM(f32x16& p0, f32x16& p1, float& m_reg, float& mn, float& alpha) {
  constexpr float C = SCALE * 1.4426950408889634f;
  float pmax = p0[0]; for (int r = 1; r < 16; ++r) pmax = fmaxf(pmax, p0[r]); for (int r = 0; r < 16; ++r) pmax = fmaxf(pmax, p1[r]);
  { auto rr = __builtin_amdgcn_permlane32_swap(__float_as_uint(pmax), __float_as_uint(pmax), false, false);
    pmax = fmaxf(__uint_as_float(rr[0]), __uint_as_float(rr[1])); }
  if (__builtin_expect(__all(pmax - m_reg <= THR / SCALE), 1)) { mn = m_reg; alpha = 1.f; }
  else { mn = fmaxf(m_reg, pmax); alpha = __builtin_amdgcn_exp2f((m_reg - mn) * C); m_reg = mn; }
  float mnC = -mn * C;
  for (int r = 0; r < 16; ++r) p0[r] = fmaf(p0[r], C, mnC); for (int r = 0; r < 16; ++r) p1[r] = fmaf(p1[r], C, mnC);
  for (int r = 0; r < 16; ++r) p0[r] = __builtin_amdgcn_exp2f(p0[r]);
}
__device__ __forceinline__ void finishSM(f32x16& p0, f32x16& p1, float alpha, float& l_reg, bf16x8& pa0, bf16x8& pa1, bf16x8& pa2, bf16x8& pa3) {
  for (int r = 0; r < 16; ++r) p1[r] = __builtin_amdgcn_exp2f(p1[r]);
  float ps = 0; for (int r = 0; r < 16; ++r) ps += p0[r]; for (int r = 0; r < 16; ++r) ps += p1[r];
  { auto rr = __builtin_amdgcn_permlane32_swap(__float_as_uint(ps), __float_as_uint(ps), false, false);
    ps = __uint_as_float(rr[0]) + __uint_as_float(rr[1]); }
  l_reg = l_reg * alpha + ps;
#define PK4(P, BASE, OUT) do { unsigned a0 = cvtpk(P[BASE + 0], P[BASE + 1]), a1 = cvtpk(P[BASE + 2], P[BASE + 3]);   \
    unsigned b0 = cvtpk(P[BASE + 4], P[BASE + 5]), b1 = cvtpk(P[BASE + 6], P[BASE + 7]);                              \
    auto r0 = __builtin_amdgcn_permlane32_swap(a0, b0, false, false); auto r1 = __builtin_amdgcn_permlane32_swap(a1, b1, false, false); \
    u32x4 w = {r0[0], r1[0], r0[1], r1[1]}; OUT = *reinterpret_cast<bf16x8*>(&w); } while (0)
  PK4(p0, 0, pa0); PK4(p0, 8, pa1); PK4(p1, 0, pa2); PK4(p1, 8, pa3);
#undef PK4
}
__device__ __forceinline__ void qkt(f32x16& p0, f32x16& p1, const bf16* Ks, const bf16x8* qr, int r32, int hi) {
  p0 = f32x16{}; p1 = f32x16{};
  for (int d0 = 0; d0 < 8; ++d0) { int cb = (d0 * 16 + hi * 8) * 2;
    bf16x8 b0 = *reinterpret_cast<const bf16x8*>((const char*)Ks + KSWZ(r32, cb));
    bf16x8 b1 = *reinterpret_cast<const bf16x8*>((const char*)Ks + KSWZ(32 + r32, cb));
    p0 = __builtin_amdgcn_mfma_f32_32x32x16_bf16(b0, qr[d0], p0, 0, 0, 0);
    p1 = __builtin_amdgcn_mfma_f32_32x32x16_bf16(b1, qr[d0], p1, 0, 0, 0); }
}
__device__ __forceinline__ int v_st(int k, int c) { const int kk = (k & ~0xC) | ((k & 4) << 1) | ((k & 8) >> 1); return ((kk >> 3) * 4 + (c >> 5)) * 512 + ((kk & 7) * 32 + (c & 31)) * 2; }
__device__ __forceinline__ int v_rd_base(int lane) { return ((lane & 3) << 3) | (((lane >> 2) & 3) << 6) | (((lane >> 4) & 1) << 5) | (((lane >> 5) & 1) << 8); }
constexpr int v_rd_off(int d0, int ks, int half) { return d0 * 512 + ks * 4096 + half * 2048; }
template <int OFF> __device__ __forceinline__ s16x4 tr_read(int vb) {
  s16x4 r; asm volatile("ds_read_b64_tr_b16 %0, %1 offset:%2" : "=&v"(r) : "v"(vb), "i"(OFF) : "memory"); return r;
}
template <int D0> __device__ __forceinline__ void pv_one(f32x16& od, int vb, bf16x8 pa0, bf16x8 pa1, bf16x8 pa2, bf16x8 pa3) {
  const s16x4 l0 = tr_read<v_rd_off(D0, 0, 0)>(vb), h0 = tr_read<v_rd_off(D0, 0, 1)>(vb), l1 = tr_read<v_rd_off(D0, 1, 0)>(vb), h1 = tr_read<v_rd_off(D0, 1, 1)>(vb);
  const s16x4 l2 = tr_read<v_rd_off(D0, 2, 0)>(vb), h2 = tr_read<v_rd_off(D0, 2, 1)>(vb), l3 = tr_read<v_rd_off(D0, 3, 0)>(vb), h3 = tr_read<v_rd_off(D0, 3, 1)>(vb);
  asm volatile("s_waitcnt lgkmcnt(0)" ::: "memory"); SBAR();
#define PK(L, H) (bf16x8){L[0], L[1], L[2], L[3], H[0], H[1], H[2], H[3]}
  od = __builtin_amdgcn_mfma_f32_32x32x16_bf16(pa0, PK(l0, h0), od, 0, 0, 0);
  od = __builtin_amdgcn_mfma_f32_32x32x16_bf16(pa1, PK(l1, h1), od, 0, 0, 0);
  od = __builtin_amdgcn_mfma_f32_32x32x16_bf16(pa2, PK(l2, h2), od, 0, 0, 0);
  od = __builtin_amdgcn_mfma_f32_32x32x16_bf16(pa3, PK(l3, h3), od, 0, 0, 0);
#undef PK
}
__device__ __forceinline__ void pv_d0(f32x16* o, int vb, bf16x8 pa0, bf16x8 pa1, bf16x8 pa2, bf16x8 pa3) {
  pv_one<0>(o[0], vb, pa0, pa1, pa2, pa3); pv_one<1>(o[1], vb, pa0, pa1, pa2, pa3); pv_one<2>(o[2], vb, pa0, pa1, pa2, pa3); pv_one<3>(o[3], vb, pa0, pa1, pa2, pa3);
}
template <int D0> __device__ __forceinline__ void pv_one_lean(f32x16& od, int vb, bf16x8 pa0, bf16x8 pa1, bf16x8 pa2, bf16x8 pa3) {
#define PK(L, H) (bf16x8){L[0], L[1], L[2], L[3], H[0], H[1], H[2], H[3]}
  { const s16x4 l0 = tr_read<v_rd_off(D0, 0, 0)>(vb), h0 = tr_read<v_rd_off(D0, 0, 1)>(vb), l1 = tr_read<v_rd_off(D0, 1, 0)>(vb), h1 = tr_read<v_rd_off(D0, 1, 1)>(vb);
    asm volatile("s_waitcnt lgkmcnt(0)" ::: "memory"); SBAR();
    od = __builtin_amdgcn_mfma_f32_32x32x16_bf16(pa0, PK(l0, h0), od, 0, 0, 0); od = __builtin_amdgcn_mfma_f32_32x32x16_bf16(pa1, PK(l1, h1), od, 0, 0, 0); }
  { const s16x4 l2 = tr_read<v_rd_off(D0, 2, 0)>(vb), h2 = tr_read<v_rd_off(D0, 2, 1)>(vb), l3 = tr_read<v_rd_off(D0, 3, 0)>(vb), h3 = tr_read<v_rd_off(D0, 3, 1)>(vb);
    asm volatile("s_waitcnt lgkmcnt(0)" ::: "memory"); SBAR();
    od = __builtin_amdgcn_mfma_f32_32x32x16_bf16(pa2, PK(l2, h2), od, 0, 0, 0); od = __builtin_amdgcn_mfma_f32_32x32x16_bf16(pa3, PK(l3, h3), od, 0, 0, 0); }
#undef PK
}
__device__ __forceinline__ void pv_d0_lean(f32x16* o, int vb, bf16x8 pa0, bf16x8 pa1, bf16x8 pa2, bf16x8 pa3) {
  pv_one_lean<0>(o[0], vb, pa0, pa1, pa2, pa3); pv_one_lean<1>(o[1], vb, pa0, pa1, pa2, pa3); pv_one_lean<2>(o[2], vb, pa0, pa1, pa2, pa3); pv_one_lean<3>(o[3], vb, pa0, pa1, pa2, pa3);
}
#define PV_RD(X, D0) do { X[0] = tr_read<v_rd_off(D0, 0, 0)>(vb); X[1] = tr_read<v_rd_off(D0, 0, 1)>(vb); X[2] = tr_read<v_rd_off(D0, 1, 0)>(vb); X[3] = tr_read<v_rd_off(D0, 1, 1)>(vb); \
    X[4] = tr_read<v_rd_off(D0, 2, 0)>(vb); X[5] = tr_read<v_rd_off(D0, 2, 1)>(vb); X[6] = tr_read<v_rd_off(D0, 3, 0)>(vb); X[7] = tr_read<v_rd_off(D0, 3, 1)>(vb); } while (0)
#define PV_PK(L, H) (bf16x8){L[0], L[1], L[2], L[3], H[0], H[1], H[2], H[3]}
#define PV_MM(X, D0) do { o[D0] = __builtin_amdgcn_mfma_f32_32x32x16_bf16(pa0, PV_PK(X[0], X[1]), o[D0], 0, 0, 0); o[D0] = __builtin_amdgcn_mfma_f32_32x32x16_bf16(pa1, PV_PK(X[2], X[3]), o[D0], 0, 0, 0); \
    o[D0] = __builtin_amdgcn_mfma_f32_32x32x16_bf16(pa2, PV_PK(X[4], X[5]), o[D0], 0, 0, 0); o[D0] = __builtin_amdgcn_mfma_f32_32x32x16_bf16(pa3, PV_PK(X[6], X[7]), o[D0], 0, 0, 0); } while (0)
__device__ __forceinline__ void pv_d0p(f32x16* o, int vb, bf16x8 pa0, bf16x8 pa1, bf16x8 pa2, bf16x8 pa3) {
  s16x4 A[8], B[8];
  SBAR(); PV_RD(A, 0); PV_RD(B, 1);
  asm volatile("s_waitcnt lgkmcnt(8)" ::: "memory"); SBAR(); PV_MM(A, 0); SBAR();
  PV_RD(A, 2);
  asm volatile("s_waitcnt lgkmcnt(8)" ::: "memory"); SBAR(); PV_MM(B, 1); SBAR();
  PV_RD(B, 3);
  asm volatile("s_waitcnt lgkmcnt(8)" ::: "memory"); SBAR(); PV_MM(A, 2); SBAR();
  asm volatile("s_waitcnt lgkmcnt(0)" ::: "memory"); SBAR(); PV_MM(B, 3);
}


constexpr float THRL = 8.f;
__device__ __forceinline__ void qkt_n(f32x16& p0, f32x16& p1, const bf16* Ks, const bf16x8* qr, const f32x16& negm, int r32, int hi) {
#pragma unroll
  for (int d0 = 0; d0 < 8; ++d0) { int cb = (d0 * 16 + hi * 8) * 2;
    bf16x8 b0 = *reinterpret_cast<const bf16x8*>((const char*)Ks + KSWZ(r32, cb));
    bf16x8 b1 = *reinterpret_cast<const bf16x8*>((const char*)Ks + KSWZ(32 + r32, cb));
    if (d0 == 0) { p0 = __builtin_amdgcn_mfma_f32_32x32x16_bf16(b0, qr[0], negm, 0, 0, 0); p1 = __builtin_amdgcn_mfma_f32_32x32x16_bf16(b1, qr[0], negm, 0, 0, 0); }
    else { p0 = __builtin_amdgcn_mfma_f32_32x32x16_bf16(b0, qr[d0], p0, 0, 0, 0); p1 = __builtin_amdgcn_mfma_f32_32x32x16_bf16(b1, qr[d0], p1, 0, 0, 0); } }
}
template <bool FIRST> __device__ __forceinline__ void partialSM_n(f32x16& p0, f32x16& p1, float& mhat, f32x16& negm, float& alpha) {
  float pmax = p0[0]; for (int r = 1; r < 16; ++r) pmax = fmaxf(pmax, p0[r]); for (int r = 0; r < 16; ++r) pmax = fmaxf(pmax, p1[r]);
  { auto rr = __builtin_amdgcn_permlane32_swap(__float_as_uint(pmax), __float_as_uint(pmax), false, false);
    pmax = fmaxf(__uint_as_float(rr[0]), __uint_as_float(rr[1])); }
  if (!FIRST && __builtin_expect(__all(pmax <= THRL), 1)) { alpha = 1.f; }
  else { const float dl = FIRST ? pmax : fmaxf(pmax, 0.f); mhat += dl;
    for (int r = 0; r < 16; ++r) { p0[r] -= dl; p1[r] -= dl; }
    for (int r = 0; r < 16; ++r) negm[r] = -mhat;
    alpha = FIRST ? 1.f : __builtin_amdgcn_exp2f(-dl); }
  for (int r = 0; r < 16; ++r) p0[r] = __builtin_amdgcn_exp2f(p0[r]);
}
template <int LDQ, int LDK, int LDO>
__device__ __forceinline__ void attn_dense_body3_n(const bf16* __restrict__ Qb, const bf16* __restrict__ Kh, const bf16* __restrict__ Vh,
                                                 unsigned short* __restrict__ Ob, int seq, char* lds, const int wave_s) {
  int tid_ = wave_s * 64 + lane_id_v();
  const int tid = tid_, wid = wave_s, lane = tid & 63, r32 = lane & 31, hi = lane >> 5;
  constexpr int BUF = (int)(SHM_V + SHM_K);
  float* ws = (float*)(lds + 3 * BUF) + wid * 64; float* li_l = ws; float* al_l = ws + 32;
  float m_reg = 0.f, l_reg = 0; f32x16 o[4] = {}; bf16x8 qr[8]; f32x16 negm = {};
  const bf16* Qw = Qb + (long)(wid * QBLK + r32) * LDQ + hi * 8;
#pragma unroll
  for (int d0 = 0; d0 < 8; ++d0) qr[d0] = ld8(Qw + d0 * 16);
  const int sr = tid >> 4, sc = (tid & 15) * 8, vst0 = v_st(sr, sc), vst1 = v_st(32 + sr, sc);
  const int vb0 = (int)(uintptr_t)lds + v_rd_base(lane);
  bf16x8 s_v0, s_v1, s_k0, s_k1;
#define SLOAD(k0) do { s_v0 = ld8(&Vh[(long)((k0) + sr) * LDK + sc]); s_v1 = ld8(&Vh[(long)((k0) + 32 + sr) * LDK + sc]); \
    s_k0 = ld8(&Kh[(long)((k0) + sr) * LDK + sc]); s_k1 = ld8(&Kh[(long)((k0) + 32 + sr) * LDK + sc]); } while (0)
#define SWRITE(boff) do { char* b_ = lds + (boff); *(bf16x8*)(b_ + vst0) = s_v0; *(bf16x8*)(b_ + vst1) = s_v1; const int kc = sc * 2;  \
    *(bf16x8*)(b_ + SHM_V + KSWZ(sr, kc)) = s_k0; *(bf16x8*)(b_ + SHM_V + KSWZ(32 + sr, kc)) = s_k1; } while (0)
#define RESC(a) do { if (__any((a) < 1.f)) { if (hi == 0) al_l[r32] = (a); asm volatile("s_waitcnt lgkmcnt(0)" ::: "memory"); \
    for (int d = 0; d < 4; ++d) for (int r = 0; r < 16; ++r) o[d][r] *= al_l[crow(r, hi)]; } } while (0)
#define ROT() do { const int t_ = b0; b0 = b1; b1 = b2; b2 = t_; } while (0)
  f32x16 pA0, pA1, pB0, pB1; float mnA, mnB, alA, alB; bf16x8 pa0, pa1, pa2, pa3; const int NT = seq / KVBLK;
  int b0 = 2 * BUF, b1 = 0, b2 = BUF;
  SLOAD(0); SWRITE(0); SLOAD(KVBLK); __syncthreads();
  SWRITE(b2); if (2 < NT) SLOAD(2 * KVBLK); SBAR();
  qkt_n(pA0, pA1, (const bf16*)(lds + b1 + SHM_V), qr, negm, r32, hi); partialSM_n<true>(pA0, pA1, m_reg, negm, alA);
  __syncthreads(); ROT();
  for (int j = 1; j + 1 < NT; j += 2) {
    SWRITE(b2); if (j + 2 < NT) SLOAD((j + 2) * KVBLK); SBAR();
    qkt_n(pB0, pB1, (const bf16*)(lds + b1 + SHM_V), qr, negm, r32, hi);
    finishSM(pA0, pA1, alA, l_reg, pa0, pa1, pa2, pa3); SBAR();
    pv_d0_lean(o, vb0 + b0, pa0, pa1, pa2, pa3); partialSM_n<false>(pB0, pB1, m_reg, negm, alB);
    RESC(alB); __syncthreads(); ROT();
    if (j + 2 < NT) SWRITE(b2); if (j + 3 < NT) SLOAD((j + 3) * KVBLK); SBAR();
    qkt_n(pA0, pA1, (const bf16*)(lds + b1 + SHM_V), qr, negm, r32, hi);
    finishSM(pB0, pB1, alB, l_reg, pa0, pa1, pa2, pa3); SBAR();
    pv_d0_lean(o, vb0 + b0, pa0, pa1, pa2, pa3); partialSM_n<false>(pA0, pA1, m_reg, negm, alA);
    RESC(alA); __syncthreads(); ROT();
  }
  SBAR(); qkt_n(pB0, pB1, (const bf16*)(lds + b1 + SHM_V), qr, negm, r32, hi);
  finishSM(pA0, pA1, alA, l_reg, pa0, pa1, pa2, pa3); SBAR();
  const int vbt = (int)(uintptr_t)lds + v_rd_base(lane_id_v());
  pv_d0_lean(o, vbt + b0, pa0, pa1, pa2, pa3); partialSM_n<false>(pB0, pB1, m_reg, negm, alB);
  RESC(alB);
  finishSM(pB0, pB1, alB, l_reg, pa0, pa1, pa2, pa3); SBAR();
  pv_d0_lean(o, vbt + b1, pa0, pa1, pa2, pa3);
  const int lane_e = lane_id_v(), r32e = lane_e & 31, hie = lane_e >> 5; float* li_e = (float*)(lds + 3 * BUF) + wave_s * 64;
  if (hie == 0) li_e[r32e] = l_reg; asm volatile("s_waitcnt lgkmcnt(0)" ::: "memory");
  float rli[16];
#pragma unroll
  for (int r = 0; r < 16; ++r) rli[r] = __builtin_amdgcn_rcpf(li_e[crow(r, hie)]);
  unsigned short* Ow = Ob + (long)(wave_s * QBLK) * LDO;
#pragma unroll
  for (int r = 0; r < 16; ++r) { int orow = crow(r, hie);
    for (int d0 = 0; d0 < 4; ++d0) { const unsigned pk = cvtpk(o[d0][r] * rli[r], 0.f); Ow[(long)orow * LDO + d0 * 32 + r32e] = (unsigned short)(pk & 0xffffu); } }
  __syncthreads();
#undef SLOAD
#undef SWRITE
#undef RESC
#undef ROT
}
__device__ __forceinline__ int v_st_n(int k, int c) { return ((k >> 3) * 4 + (c >> 5)) * 512 + ((k & 7) * 32 + (c & 31)) * 2; }
typedef int v8i __attribute__((ext_vector_type(8)));
typedef short v2s __attribute__((ext_vector_type(2)));
#define K8OFF(row, colB) ((row) * 128 + ((colB) ^ ((((row) >> 1) & 7) << 4)))
#define V8OFF(d, colB) ((d) * 64 + ((colB) ^ ((((d) >> 2) & 3) << 4)))
#define PIN(x) asm volatile("" : "+v"(x))
__device__ __forceinline__ v8i k8frag(const char* Kt, int row, int colB) {
  const u32x4 lo = *(const u32x4*)(Kt + K8OFF(row, colB)), hi4 = *(const u32x4*)(Kt + K8OFF(row, colB + 16));
  return (v8i){(int)lo.x, (int)lo.y, (int)lo.z, (int)lo.w, (int)hi4.x, (int)hi4.y, (int)hi4.z, (int)hi4.w};
}
__device__ __forceinline__ v8i v8frag(const char* Vt, int d, int colB) {
  const u32x4 lo = *(const u32x4*)(Vt + V8OFF(d, colB)), hi4 = *(const u32x4*)(Vt + V8OFF(d, colB + 16));
  return (v8i){(int)lo.x, (int)lo.y, (int)lo.z, (int)lo.w, (int)hi4.x, (int)hi4.y, (int)hi4.z, (int)hi4.w};
}
__device__ __forceinline__ void finishSM_z(const f32x16& p0, f32x16& p1, float scl, v8i& P8) {
  for (int r = 0; r < 16; ++r) p1[r] = __builtin_amdgcn_exp2f(p1[r]);
#pragma unroll
  for (int k = 0; k < 4; ++k) { v2s w, u; asm volatile("" : "=v"(w)); asm volatile("" : "=v"(u));
    w = __builtin_amdgcn_cvt_scalef32_pk_fp8_f32(w, p0[4 * k], p0[4 * k + 1], scl, false); w = __builtin_amdgcn_cvt_scalef32_pk_fp8_f32(w, p0[4 * k + 2], p0[4 * k + 3], scl, true);
    u = __builtin_amdgcn_cvt_scalef32_pk_fp8_f32(u, p1[4 * k], p1[4 * k + 1], scl, false); u = __builtin_amdgcn_cvt_scalef32_pk_fp8_f32(u, p1[4 * k + 2], p1[4 * k + 3], scl, true);
    P8[k] = __builtin_bit_cast(int, w); P8[4 + k] = __builtin_bit_cast(int, u); }
  PIN(P8);
}
template <int LDO, int NT>
__device__ __forceinline__ void attn_dense_body10_f8(const unsigned char* __restrict__ Q8b, const unsigned char* __restrict__ K8h, const unsigned char* __restrict__ V8b,
                                                   unsigned short* __restrict__ Ob, char* lds, __attribute__((address_space(3))) unsigned char* ldsl, const int wave_s) {
  int tid_ = wave_s * 64 + lane_id_v();
  const int tid = tid_, wid = wave_s, lane = tid & 63, r32 = lane & 31, hi = lane >> 5;
  constexpr int BUF = 16384;
  float* ws = (float*)(lds + 6 * BUF) + wid * 64; float* al_l = ws + 32;
  float Ef = -1e30f, thr = -1e30f, scl = 1.f; f32x16 o[4] = {}, lacc = {};
  v8i qf[2], ones;
  { const unsigned char* Qw = Q8b + (long)(wid * QBLK + r32) * 1024 + hi * 32;
#pragma unroll
    for (int s = 0; s < 2; ++s) { const u32x4 lo = *(const u32x4*)(Qw + 64 * s), hi4 = *(const u32x4*)(Qw + 64 * s + 16); qf[s] = (v8i){(int)lo.x, (int)lo.y, (int)lo.z, (int)lo.w, (int)hi4.x, (int)hi4.y, (int)hi4.z, (int)hi4.w}; }
    for (int k = 0; k < 8; ++k) ones[k] = 0x38383838; PIN(ones); }
  const unsigned kgo = (unsigned)((tid >> 3) * 256 + (((tid & 7) ^ ((tid >> 4) & 7)) << 4));
  const unsigned vgo = (unsigned)((tid >> 2) * 64 + (((tid & 3) ^ ((tid >> 4) & 3)) << 4));
  const unsigned ldsw = (unsigned)wid * 1024u;
  constexpr int SA = 0, SB = 0, S1 = 0;
#define SDMA(k0, boff) do { \
    __builtin_amdgcn_global_load_lds((const unsigned*)(K8h + (long)(k0) * 256 + kgo), (__attribute__((address_space(3))) unsigned*)(ldsl + (boff) + 8192 + ldsw), 16, 0, 0); \
    __builtin_amdgcn_global_load_lds((const unsigned*)(V8b + (long)((k0) >> 6) * 8192 + vgo), (__attribute__((address_space(3))) unsigned*)(ldsl + (boff) + ldsw), 16, 0, 0); } while (0)
#define QK(P0, P1, boff) do { const char* Kt_ = lds + (boff) + 8192; const f32x16 z_ = {}; \
    const v8i a00 = k8frag(Kt_, r32, 32 * hi), a10 = k8frag(Kt_, 32 + r32, 32 * hi), a01 = k8frag(Kt_, r32, 64 + 32 * hi), a11 = k8frag(Kt_, 32 + r32, 64 + 32 * hi); \
    P0 = __builtin_amdgcn_mfma_scale_f32_32x32x64_f8f6f4(a00, qf[0], z_, 0, 0, 0, SA, 0, SB); P1 = __builtin_amdgcn_mfma_scale_f32_32x32x64_f8f6f4(a10, qf[0], z_, 0, 0, 0, SA, 0, SB); \
    P0 = __builtin_amdgcn_mfma_scale_f32_32x32x64_f8f6f4(a01, qf[1], P0, 0, 0, 0, SA, 0, SB); P1 = __builtin_amdgcn_mfma_scale_f32_32x32x64_f8f6f4(a11, qf[1], P1, 0, 0, 0, SA, 0, SB); } while (0)
#define PV(boff) do { const char* Vt_ = lds + (boff); \
    { const v8i b0_ = v8frag(Vt_, r32, 32 * hi), b1_ = v8frag(Vt_, 32 + r32, 32 * hi); \
      lacc = __builtin_amdgcn_mfma_scale_f32_32x32x64_f8f6f4(P8, ones, lacc, 0, 0, 0, S1, 0, S1); \
      o[0] = __builtin_amdgcn_mfma_scale_f32_32x32x64_f8f6f4(P8, b0_, o[0], 0, 0, 0, S1, 0, S1); o[1] = __builtin_amdgcn_mfma_scale_f32_32x32x64_f8f6f4(P8, b1_, o[1], 0, 0, 0, S1, 0, S1); } \
    { const v8i b2_ = v8frag(Vt_, 64 + r32, 32 * hi), b3_ = v8frag(Vt_, 96 + r32, 32 * hi); \
      o[2] = __builtin_amdgcn_mfma_scale_f32_32x32x64_f8f6f4(P8, b2_, o[2], 0, 0, 0, S1, 0, S1); o[3] = __builtin_amdgcn_mfma_scale_f32_32x32x64_f8f6f4(P8, b3_, o[3], 0, 0, 0, S1, 0, S1); } } while (0)
#define PARTMAX(P0, P1) do { pm = fmaxf(P0[0], P1[0]); for (int r_ = 1; r_ < 16; ++r_) pm = fmaxf(fmaxf(pm, P0[r_]), P1[r_]); \
    { auto rr_ = __builtin_amdgcn_permlane32_swap(__float_as_uint(pm), __float_as_uint(pm), false, false); pm = fmaxf(__uint_as_float(rr_[0]), __uint_as_float(rr_[1])); } \
    for (int r_ = 0; r_ < 16; ++r_) P0[r_] = __builtin_amdgcn_exp2f(P0[r_]); PIN(P0); PIN(pm); } while (0)
#define ADJ() do { if (__any(pm > thr)) { const float want_ = ceilf(pm - 7.f), En_ = (pm > thr) ? want_ : Ef; const float al_ = __builtin_amdgcn_exp2f(Ef - En_); \
      Ef = En_; thr = En_ + 8.f; scl = __int_as_float(((int)En_ + 127) << 23); \
      if (hi == 0) al_l[r32] = al_; asm volatile("s_waitcnt lgkmcnt(0)" ::: "memory"); \
      for (int r_ = 0; r_ < 16; ++r_) { const float f_ = al_l[crow(r_, hi)]; for (int d_ = 0; d_ < 4; ++d_) o[d_][r_] *= f_; lacc[r_] *= f_; } } } while (0)
#define PAIR_SYNC() do { asm volatile("s_waitcnt vmcnt(0)" ::: "memory"); __builtin_amdgcn_s_barrier(); } while (0)
#define STEP(PN0, PN1, PO0, PO1, BQ, BP) do { \
    SBAR(); QK(PN0, PN1, (BQ) * BUF); finishSM_z(PO0, PO1, scl, P8); PIN(PN0); PIN(PN1); SBAR(); \
    PV((BP) * BUF); PARTMAX(PN0, PN1); SBAR(); ADJ(); } while (0)
#define PAIR(B, T) do { SDMA(min((T) + 2, NT - 1) * KVBLK, (((B) + 2) % 6) * BUF); SDMA(min((T) + 3, NT - 1) * KVBLK, (((B) + 3) % 6) * BUF); \
    STEP(pB0, pB1, pA0, pA1, (B), ((B) + 5) % 6); STEP(pA0, pA1, pB0, pB1, ((B) + 1) % 6, (B)); PAIR_SYNC(); } while (0)
  f32x16 pA0, pA1, pB0, pB1; float pm; v8i P8;
  SDMA(0, 0); SDMA(KVBLK, BUF); SDMA(2 * KVBLK, 2 * BUF); PAIR_SYNC();
  SBAR(); QK(pA0, pA1, 0); PARTMAX(pA0, pA1); SBAR(); ADJ();
  static_assert((NT - 2) % 6 == 0, "tile count");
#pragma nounroll
  for (int j = 1; j + 1 < NT; j += 6) { PAIR(1, j); PAIR(3, j + 2); PAIR(5, j + 4); }
  SBAR(); QK(pB0, pB1, 1 * BUF); finishSM_z(pA0, pA1, scl, P8); PIN(pB0); PIN(pB1); SBAR();
  PV(0 * BUF); PARTMAX(pB0, pB1); SBAR(); ADJ();
  finishSM_z(pB0, pB1, scl, P8); SBAR();
  PV(1 * BUF);
  asm volatile("s_waitcnt vmcnt(0)" ::: "memory");
  const int lane_e = lane_id_v(), r32e = lane_e & 31, hie = lane_e >> 5;
  unsigned short* Ow = Ob + (long)(wave_s * QBLK) * LDO;
#pragma unroll
  for (int r = 0; r < 16; ++r) { const int orow = crow(r, hie); const float rl = __builtin_amdgcn_rcpf(lacc[r]);
    for (int d0 = 0; d0 < 4; ++d0) { const unsigned pk = cvtpk(o[d0][r] * rl, 0.f); Ow[(long)orow * LDO + d0 * 32 + r32e] = (unsigned short)(pk & 0xffffu); } }
  __syncthreads();
#undef SDMA
#undef QK
#undef PV
#undef PARTMAX
#undef ADJ
#undef PAIR_SYNC
#undef STEP
#undef PAIR
}
#undef V8OFF
#undef K8OFF
constexpr int SWA_TABN = 448;
constexpr float THR2 = 8.f;
__device__ __forceinline__ void partialSM_b(f32x16& p0, f32x16& p1, const float* tbj, float& m_reg, float& mn, float& alpha) {
  constexpr float C = SCALE * 1.4426950408889634f;
#pragma unroll
  for (int r = 0; r < 16; ++r) { const int o = (r & 3) + 8 * (r >> 2); p0[r] = fmaf(p0[r], C, tbj[o]); p1[r] = fmaf(p1[r], C, tbj[o + 32]); }
  float pmax = p0[0]; for (int r = 1; r < 16; ++r) pmax = fmaxf(pmax, p0[r]); for (int r = 0; r < 16; ++r) pmax = fmaxf(pmax, p1[r]);
  { auto rr = __builtin_amdgcn_permlane32_swap(__float_as_uint(pmax), __float_as_uint(pmax), false, false);
    pmax = fmaxf(__uint_as_float(rr[0]), __uint_as_float(rr[1])); }
  if (__builtin_expect(__all(pmax - m_reg <= THR2), 1)) { mn = m_reg; alpha = 1.f; }
  else { mn = fmaxf(m_reg, pmax); alpha = __builtin_amdgcn_exp2f(m_reg - mn); m_reg = mn; }
  for (int r = 0; r < 16; ++r) p0[r] -= mn; for (int r = 0; r < 16; ++r) p1[r] -= mn;
  for (int r = 0; r < 16; ++r) p0[r] = __builtin_amdgcn_exp2f(p0[r]);
}
template <int LD, int CQ, int CK, int CV, int SEQ_>
__device__ __forceinline__ void swa_unit(unsigned short* PROJ_, unsigned short* Obase, int ldo, int b, int kvh, int qblk, const float* sinkp, const float* tab, char* lds, const int wave_s) {
  int tid_ = wave_s * 64 + lane_id_v();
  const int tid = tid_, wid = wave_s, lane = tid & 63, r32 = lane & 31, hi = lane >> 5;
  bf16* V_lds = (bf16*)lds; bf16* K_lds = (bf16*)(lds + 2 * SHM_V);
  float* ws = (float*)(lds + 2 * SHM_V + 2 * SHM_K) + wid * 64; float* li_l = ws; float* al_l = ws + 32;
  const int g = wid >> 1, half = wid & 1, hq = kvh * 4 + g, q0 = qblk * 64, kb = q0 - 128;
  bf16* PROJ = (bf16*)PROJ_;
  bf16* Qrow0 = PROJ + ((long)b * SEQ_ + q0 + 32 * half) * LD + CQ + hq * 128;
  const bf16* Kh = PROJ + (long)b * SEQ_ * LD + CK + kvh * 128; const bf16* Vh = PROJ + (long)b * SEQ_ * LD + CV + kvh * 128;
  float m_reg = sinkp[hq] * 1.4426950408889634f, l_reg = 1.f; f32x16 o[4] = {}; bf16x8 qr[8];
  const bf16* Qw = Qrow0 + (long)r32 * LD + hi * 8;
#pragma unroll
  for (int d0 = 0; d0 < 8; ++d0) qr[d0] = ld8(Qw + d0 * 16);
  const float* tb = tab + hq * SWA_TABN + 64 + 4 * hi - 32 * half - r32;
  const float* tmask = tab + hq * SWA_TABN;
  const int sr = tid >> 4, sc = (tid & 15) * 8, vst0 = v_st(sr, sc), vst1 = v_st(32 + sr, sc);
  const int vb0 = (int)(uintptr_t)V_lds + v_rd_base(lane);
  struct { bf16x8 vs0, vs1, ks0, ks1; } sr_[2];
#define TROW(j) ({ int k_ = kb + 64 * (j); k_ = k_ < 0 ? 0 : (k_ > SEQ_ - 64 ? SEQ_ - 64 : k_); k_; })
#define TBJ(j) (((unsigned)(kb + 64 * (j)) < (unsigned)SEQ_) ? (tb + 64 * (j)) : tmask)
#define SLOAD(i, k0) do { sr_[i].vs0 = ld8(&Vh[(long)((k0) + sr) * LD + sc]); sr_[i].vs1 = ld8(&Vh[(long)((k0) + 32 + sr) * LD + sc]); \
    sr_[i].ks0 = ld8(&Kh[(long)((k0) + sr) * LD + sc]); sr_[i].ks1 = ld8(&Kh[(long)((k0) + 32 + sr) * LD + sc]); } while (0)
#define SWRITE(b_, i) do { *(bf16x8*)((char*)V_lds + (b_) * SHM_V + vst0) = sr_[i].vs0;          \
    *(bf16x8*)((char*)V_lds + (b_) * SHM_V + vst1) = sr_[i].vs1; int kc = sc * 2;               \
    *(bf16x8*)((char*)K_lds + (b_) * SHM_K + KSWZ(sr, kc)) = sr_[i].ks0;                       \
    *(bf16x8*)((char*)K_lds + (b_) * SHM_K + KSWZ(32 + sr, kc)) = sr_[i].ks1; } while (0)
#define SWAIT() asm volatile("s_waitcnt vmcnt(4)" ::: "memory")
#define RESC(a) do { if (__any((a) < 1.f)) { if (hi == 0) al_l[r32] = (a); asm volatile("s_waitcnt lgkmcnt(0)" ::: "memory"); \
    for (int d = 0; d < 4; ++d) for (int r = 0; r < 16; ++r) o[d][r] *= al_l[crow(r, hi)]; } } while (0)
  f32x16 pA0, pA1, pB0, pB1; float mnA, mnB, alA, alB; bf16x8 pa0, pa1, pa2, pa3;
  constexpr int SE = 0, SO = 1;
  SLOAD(SE, TROW(0)); asm volatile("s_waitcnt vmcnt(0)" ::: "memory"); SWRITE(0, SE); __syncthreads();
  qkt(pA0, pA1, K_lds, qr, r32, hi); partialSM_b(pA0, pA1, TBJ(0), m_reg, mnA, alA);
  SLOAD(SO, TROW(1)); SLOAD(SE, TROW(2));
  SWAIT(); SWRITE(1, SO); __syncthreads();
#pragma unroll
  for (int j = 1; j < 4; j += 2) {
    SBAR(); qkt(pB0, pB1, (bf16*)((char*)K_lds + SHM_K), qr, r32, hi);
    finishSM(pA0, pA1, alA, l_reg, pa0, pa1, pa2, pa3); SBAR();
    if (j + 2 < 5) SLOAD(SO, TROW(j + 2)); SBAR();
    pv_d0(o, vb0, pa0, pa1, pa2, pa3); partialSM_b(pB0, pB1, TBJ(j), m_reg, mnB, alB);
    __syncthreads(); SWAIT(); SWRITE(0, SE);
    RESC(alB); __syncthreads();
    SBAR(); qkt(pA0, pA1, K_lds, qr, r32, hi);
    finishSM(pB0, pB1, alB, l_reg, pa0, pa1, pa2, pa3); SBAR();
    if (j + 3 < 5) SLOAD(SE, TROW(j + 3)); SBAR();
    pv_d0(o, vb0 + (int)SHM_V, pa0, pa1, pa2, pa3); partialSM_b(pA0, pA1, TBJ(j + 1), m_reg, mnA, alA);
    if (j + 2 < 5) { __syncthreads(); SWAIT(); SWRITE(1, SO); RESC(alA); __syncthreads(); } else { RESC(alA); }
  }
  finishSM(pA0, pA1, alA, l_reg, pa0, pa1, pa2, pa3); SBAR();
  pv_d0(o, vb0, pa0, pa1, pa2, pa3);
  if (hi == 0) li_l[r32] = l_reg; asm volatile("s_waitcnt lgkmcnt(0)" ::: "memory");
  float rli[16];
#pragma unroll
  for (int r = 0; r < 16; ++r) rli[r] = __builtin_amdgcn_rcpf(li_l[crow(r, hi)]);
  unsigned short* Ow = Obase + ((long)b * SEQ_ + q0 + 32 * half) * ldo + hq * 128;
#pragma unroll
  for (int r = 0; r < 16; ++r) { int orow = crow(r, hi);
    for (int d0 = 0; d0 < 4; ++d0) { const unsigned pk = cvtpk(o[d0][r] * rli[r], 0.f); Ow[(long)orow * ldo + d0 * 32 + r32] = (unsigned short)(pk & 0xffffu); } }
  __syncthreads();
#undef TROW
#undef TBJ
#undef SLOAD
#undef SWRITE
#undef SWAIT
#undef RESC
}

__device__ __forceinline__ bf16x8 scale8(bf16x8 v, float w) {
  const u32x4 u = __builtin_bit_cast(u32x4, v); u32x4 o;
  o.x = cvtpk(__uint_as_float(u.x << 16) * w, __uint_as_float(u.x & 0xffff0000u) * w); o.y = cvtpk(__uint_as_float(u.y << 16) * w, __uint_as_float(u.y & 0xffff0000u) * w);
  o.z = cvtpk(__uint_as_float(u.z << 16) * w, __uint_as_float(u.z & 0xffff0000u) * w); o.w = cvtpk(__uint_as_float(u.w << 16) * w, __uint_as_float(u.w & 0xffff0000u) * w);
  return __builtin_bit_cast(bf16x8, o);
}
#define PKF(L, H) (bf16x8){L[0], L[1], L[2], L[3], H[0], H[1], H[2], H[3]}
template <int JH, int KS> __device__ __forceinline__ void ret_u_step(f32x16* aF, f32x16* aB, int vbV, int vbKf, int vbKb) {
  const s16x4 bl = tr_read<JH * 32768 + KS * 4096>(vbV), bh = tr_read<JH * 32768 + KS * 4096 + 2048>(vbV);
  const s16x4 f0l = tr_read<JH * 16384 + 0 * 512 + KS * 4096>(vbKf), f0h = tr_read<JH * 16384 + 0 * 512 + KS * 4096 + 2048>(vbKf);
  const s16x4 f1l = tr_read<JH * 16384 + 1 * 512 + KS * 4096>(vbKf), f1h = tr_read<JH * 16384 + 1 * 512 + KS * 4096 + 2048>(vbKf);
  const s16x4 f2l = tr_read<JH * 16384 + 2 * 512 + KS * 4096>(vbKf), f2h = tr_read<JH * 16384 + 2 * 512 + KS * 4096 + 2048>(vbKf);
  const s16x4 f3l = tr_read<JH * 16384 + 3 * 512 + KS * 4096>(vbKf), f3h = tr_read<JH * 16384 + 3 * 512 + KS * 4096 + 2048>(vbKf);
  const s16x4 g0l = tr_read<JH * 16384 + 0 * 512 + KS * 4096>(vbKb), g0h = tr_read<JH * 16384 + 0 * 512 + KS * 4096 + 2048>(vbKb);
  const s16x4 g1l = tr_read<JH * 16384 + 1 * 512 + KS * 4096>(vbKb), g1h = tr_read<JH * 16384 + 1 * 512 + KS * 4096 + 2048>(vbKb);
  const s16x4 g2l = tr_read<JH * 16384 + 2 * 512 + KS * 4096>(vbKb), g2h = tr_read<JH * 16384 + 2 * 512 + KS * 4096 + 2048>(vbKb);
  const s16x4 g3l = tr_read<JH * 16384 + 3 * 512 + KS * 4096>(vbKb), g3h = tr_read<JH * 16384 + 3 * 512 + KS * 4096 + 2048>(vbKb);
  asm volatile("s_waitcnt lgkmcnt(0)" ::: "memory"); SBAR();
  const bf16x8 B = PKF(bl, bh);
  aF[0] = __builtin_amdgcn_mfma_f32_32x32x16_bf16(PKF(f0l, f0h), B, aF[0], 0, 0, 0); aF[1] = __builtin_amdgcn_mfma_f32_32x32x16_bf16(PKF(f1l, f1h), B, aF[1], 0, 0, 0);
  aF[2] = __builtin_amdgcn_mfma_f32_32x32x16_bf16(PKF(f2l, f2h), B, aF[2], 0, 0, 0); aF[3] = __builtin_amdgcn_mfma_f32_32x32x16_bf16(PKF(f3l, f3h), B, aF[3], 0, 0, 0);
  aB[0] = __builtin_amdgcn_mfma_f32_32x32x16_bf16(PKF(g0l, g0h), B, aB[0], 0, 0, 0); aB[1] = __builtin_amdgcn_mfma_f32_32x32x16_bf16(PKF(g1l, g1h), B, aB[1], 0, 0, 0);
  aB[2] = __builtin_amdgcn_mfma_f32_32x32x16_bf16(PKF(g2l, g2h), B, aB[2], 0, 0, 0); aB[3] = __builtin_amdgcn_mfma_f32_32x32x16_bf16(PKF(g3l, g3h), B, aB[3], 0, 0, 0);
}
template <int LD, int CK, int CV>
__device__ __forceinline__ void ret_u_unit(const unsigned short* PROJ_, unsigned short* UF, unsigned short* UB, long row0, int h, float lf2, float lb2, char* lds, const int wave_s) {
  int tid_ = wave_s * 64 + lane_id_v();
  const int tid = tid_, wid = wave_s, lane = tid & 63, r32 = lane & 31, hi = lane >> 5;
  const bf16* PROJ = (const bf16*)PROJ_;
  char* Vimg = lds; char* Kf = lds + 65536; char* Kb = lds + 98304;
  const int sr = tid >> 4, sc = (tid & 15) * 8, vst0 = v_st(sr, sc), vst1 = v_st(32 + sr, sc);
  const bf16* Kg = PROJ + row0 * LD + CK + h * 128 + sc; const bf16* Vg = PROJ + row0 * LD + CV + h * 256 + sc;
  __syncthreads();
#pragma unroll
  for (int jh = 0; jh < 2; ++jh)
#pragma unroll
    for (int q = 0; q < 2; ++q) { const int j = 64 * jh + 32 * q + sr, vst = q ? vst1 : vst0;
      const bf16x8 k8 = ld8(Kg + (long)j * LD), v0 = ld8(Vg + (long)j * LD), v1 = ld8(Vg + (long)j * LD + 128);
      const float wf = __builtin_amdgcn_exp2f((float)(127 - j) * lf2), wb = __builtin_amdgcn_exp2f((float)j * lb2);
      *(bf16x8*)(Kf + jh * 16384 + vst) = scale8(k8, wf); *(bf16x8*)(Kb + jh * 16384 + vst) = scale8(k8, wb);
      *(bf16x8*)(Vimg + (jh * 2 + 0) * 16384 + vst) = v0; *(bf16x8*)(Vimg + (jh * 2 + 1) * 16384 + vst) = v1; }
  __syncthreads();
  const int vbV = (int)(uintptr_t)Vimg + (wid >> 2) * 16384 + v_rd_base(lane) + (wid & 3) * 512;
  const int vbKf = (int)(uintptr_t)Kf + v_rd_base(lane), vbKb = (int)(uintptr_t)Kb + v_rd_base(lane);
  f32x16 aF[4] = {}, aB[4] = {};
  ret_u_step<0, 0>(aF, aB, vbV, vbKf, vbKb); ret_u_step<0, 1>(aF, aB, vbV, vbKf, vbKb); ret_u_step<0, 2>(aF, aB, vbV, vbKf, vbKb); ret_u_step<0, 3>(aF, aB, vbV, vbKf, vbKb);
  ret_u_step<1, 0>(aF, aB, vbV, vbKf, vbKb); ret_u_step<1, 1>(aF, aB, vbV, vbKf, vbKb); ret_u_step<1, 2>(aF, aB, vbV, vbKf, vbKb); ret_u_step<1, 3>(aF, aB, vbV, vbKf, vbKb);
  __syncthreads();
  char* stg = lds + wid * 8704;
#pragma unroll
  for (int dir = 0; dir < 2; ++dir) { unsigned short* U = dir ? UB : UF;
#pragma unroll
    for (int c = 0; c < 4; ++c)
#pragma unroll
      for (int rq = 0; rq < 4; ++rq) { const f32x16& v = dir ? aB[c] : aF[c];
        *(unsigned long long*)(stg + r32 * 272 + (32 * c + 8 * rq + 4 * hi) * 2) = (unsigned long long)cvtpk_m(v[4 * rq], v[4 * rq + 1]) | ((unsigned long long)cvtpk_m(v[4 * rq + 2], v[4 * rq + 3]) << 32); }
#pragma unroll
    for (int i = 0; i < 8; ++i) { const int ch_ = i * 64 + lane, row = ch_ >> 4, ch = ch_ & 15;
      const u32x4 w = *(const u32x4*)(stg + row * 272 + ch * 16); *(u32x4*)(U + (long)(32 * wid + row) * 128 + ch * 8) = w; } }
}
template <int T> __device__ __forceinline__ void ret_o_pv(f32x16* acc, int vbV, bf16x8 pa0, bf16x8 pa1, bf16x8 pa2, bf16x8 pa3) {
#define RO_ONE(D0) { \
    const s16x4 l0 = tr_read<T * 32768 + v_rd_off(D0, 0, 0)>(vbV), h0 = tr_read<T * 32768 + v_rd_off(D0, 0, 1)>(vbV), l1 = tr_read<T * 32768 + v_rd_off(D0, 1, 0)>(vbV), h1 = tr_read<T * 32768 + v_rd_off(D0, 1, 1)>(vbV); \
    const s16x4 l2 = tr_read<T * 32768 + v_rd_off(D0, 2, 0)>(vbV), h2 = tr_read<T * 32768 + v_rd_off(D0, 2, 1)>(vbV), l3 = tr_read<T * 32768 + v_rd_off(D0, 3, 0)>(vbV), h3 = tr_read<T * 32768 + v_rd_off(D0, 3, 1)>(vbV); \
    asm volatile("s_waitcnt lgkmcnt(0)" ::: "memory"); SBAR(); \
    acc[D0] = __builtin_amdgcn_mfma_f32_32x32x16_bf16(PKF(l0, h0), pa0, acc[D0], 0, 0, 0); acc[D0] = __builtin_amdgcn_mfma_f32_32x32x16_bf16(PKF(l1, h1), pa1, acc[D0], 0, 0, 0); \
    acc[D0] = __builtin_amdgcn_mfma_f32_32x32x16_bf16(PKF(l2, h2), pa2, acc[D0], 0, 0, 0); acc[D0] = __builtin_amdgcn_mfma_f32_32x32x16_bf16(PKF(l3, h3), pa3, acc[D0], 0, 0, 0); }
  RO_ONE(0) RO_ONE(1) RO_ONE(2) RO_ONE(3)
#undef RO_ONE
}
template <int LD, int CQ, int CK, int CV, int CG>
__device__ __forceinline__ void ret_o_unit(unsigned short* PROJ_, unsigned short* Obase, int ldo, const unsigned short* PF_, const unsigned short* PB_, const float* gn, long row0, int h, float lf2, float lb2, char* lds, const int wave_s) {
  int tid_ = wave_s * 64 + lane_id_v();
  const int tid = tid_, wid = wave_s, lane = tid & 63, r32 = lane & 31, hi = lane >> 5;
  bf16* PROJ = (bf16*)PROJ_; const bf16* PF = (const bf16*)PF_; const bf16* PB = (const bf16*)PB_;
  char* Kimg = lds; char* Vimg = lds + 32768; float* xs = (float*)(lds + 98304);
  const int sr = tid >> 4, sc = (tid & 15) * 8, vst0 = v_st(sr, sc), vst1 = v_st(32 + sr, sc);
  const int rb = wid & 3, eh = wid >> 2, rr = 32 * rb + r32;
  const bf16* Kg = PROJ + row0 * LD + CK + h * 128 + sc; const bf16* Vg = PROJ + row0 * LD + CV + h * 256 + sc;
  bf16x8 qr[8], st[16], kv[12];
  { const bf16* Qw = PROJ + (row0 + rr) * LD + CQ + h * 128 + hi * 8;
#pragma unroll
    for (int d0 = 0; d0 < 8; ++d0) qr[d0] = ld8(Qw + d0 * 16); }
#pragma unroll
  for (int et = 0; et < 4; ++et)
#pragma unroll
    for (int q = 0; q < 2; ++q) { const long eo = (long)(64 * et + 32 * q + sr) * 128 + sc; st[et * 2 + q] = ld8(PF + eo); st[8 + et * 2 + q] = ld8(PB + eo); }
#pragma unroll
  for (int jh = 0; jh < 2; ++jh)
#pragma unroll
    for (int q = 0; q < 2; ++q) { const long j = 64 * jh + 32 * q + sr; kv[(jh * 2 + q) * 3 + 0] = ld8(Kg + j * LD); kv[(jh * 2 + q) * 3 + 1] = ld8(Vg + j * LD); kv[(jh * 2 + q) * 3 + 2] = ld8(Vg + j * LD + 128); }
  __syncthreads();
#pragma unroll
  for (int et = 0; et < 4; ++et)
#pragma unroll
    for (int q = 0; q < 2; ++q) { const int o_ = et * 16384 + KSWZ(32 * q + sr, sc * 2); *(bf16x8*)(lds + o_) = st[et * 2 + q]; *(bf16x8*)(lds + 65536 + o_) = st[8 + et * 2 + q]; }
  __syncthreads();
  f32x16 acc[4] = {};
  { const float wfr = __builtin_amdgcn_exp2f((float)(rr + 1) * lf2), wbr = __builtin_amdgcn_exp2f((float)(128 - rr) * lb2);
#pragma unroll
    for (int s = 0; s < 8; ++s) { const bf16x8 qf = scale8(qr[s], wfr), qb = scale8(qr[s], wbr); const int cb = (s * 16 + hi * 8) * 2;
#pragma unroll
      for (int eb = 0; eb < 4; ++eb) { const int o_ = (2 * eh + (eb >> 1)) * 16384 + KSWZ(32 * (eb & 1) + r32, cb);
        const bf16x8 af = *(const bf16x8*)(lds + o_), ab = *(const bf16x8*)(lds + 65536 + o_);
        acc[eb] = __builtin_amdgcn_mfma_f32_32x32x16_bf16(af, qf, acc[eb], 0, 0, 0); acc[eb] = __builtin_amdgcn_mfma_f32_32x32x16_bf16(ab, qb, acc[eb], 0, 0, 0); } } }
  __syncthreads();
#pragma unroll
  for (int jh = 0; jh < 2; ++jh)
#pragma unroll
    for (int q = 0; q < 2; ++q) { const int jl = 32 * q + sr, vst = q ? vst1 : vst0;
      *(bf16x8*)(Kimg + jh * 16384 + KSWZ(jl, sc * 2)) = kv[(jh * 2 + q) * 3 + 0];
      *(bf16x8*)(Vimg + (jh * 2 + 0) * 16384 + vst) = kv[(jh * 2 + q) * 3 + 1]; *(bf16x8*)(Vimg + (jh * 2 + 1) * 16384 + vst) = kv[(jh * 2 + q) * 3 + 2]; }
  __syncthreads();
  const int vbV = (int)(uintptr_t)Vimg + eh * 16384 + v_rd_base(lane);
#pragma unroll
  for (int t = 0; t < 2; ++t) {
    f32x16 p0, p1; qkt(p0, p1, (const bf16*)(Kimg + t * 16384), qr, r32, hi);
#pragma unroll
    for (int r = 0; r < 16; ++r) { const int j0 = 64 * t + crow(r, hi), d0 = rr - j0, d1 = d0 - 32;
      p0[r] *= __builtin_amdgcn_exp2f((float)d0 * (d0 >= 0 ? lf2 : -lb2)); p1[r] *= __builtin_amdgcn_exp2f((float)d1 * (d1 >= 0 ? lf2 : -lb2)); }
    bf16x8 pa0, pa1, pa2, pa3;
#define PK4(P, BASE, OUT) do { unsigned a0 = cvtpk(P[BASE + 0], P[BASE + 1]), a1 = cvtpk(P[BASE + 2], P[BASE + 3]);   \
    unsigned b0 = cvtpk(P[BASE + 4], P[BASE + 5]), b1 = cvtpk(P[BASE + 6], P[BASE + 7]);                              \
    auto r0 = __builtin_amdgcn_permlane32_swap(a0, b0, false, false); auto r1 = __builtin_amdgcn_permlane32_swap(a1, b1, false, false); \
    u32x4 w = {r0[0], r1[0], r0[1], r1[1]}; OUT = *reinterpret_cast<bf16x8*>(&w); } while (0)
    PK4(p0, 0, pa0); PK4(p0, 8, pa1); PK4(p1, 0, pa2); PK4(p1, 8, pa3);
#undef PK4
    SBAR();
    if (t == 0) ret_o_pv<0>(acc, vbV, pa0, pa1, pa2, pa3); else ret_o_pv<1>(acc, vbV, pa0, pa1, pa2, pa3);
  }
  float ss = 0.f;
#pragma unroll
  for (int eb = 0; eb < 4; ++eb)
#pragma unroll
    for (int r = 0; r < 16; ++r) ss += acc[eb][r] * acc[eb][r];
  { auto sw = __builtin_amdgcn_permlane32_swap(__float_as_uint(ss), __float_as_uint(ss), false, false); ss = __uint_as_float(sw[0]) + __uint_as_float(sw[1]); }
  if (hi == 0) xs[wid * 32 + r32] = ss;
  __syncthreads();
  const float tot = xs[wid * 32 + r32] + xs[(wid ^ 4) * 32 + r32];
  const float rn = 1.0f / sqrtf(tot * (1.0f / 256.0f) + 1e-6f);
  { char* stg = lds + wid * 8704; const long grow0 = row0 + 32 * rb;
#pragma unroll
    for (int half = 0; half < 2; ++half) {
#pragma unroll
      for (int e2 = 0; e2 < 2; ++e2)
#pragma unroll
        for (int rq = 0; rq < 4; ++rq) { const f32x16& v = acc[2 * half + e2];
          *(float4*)(stg + r32 * 272 + (32 * e2 + 8 * rq + 4 * hi) * 4) = make_float4(v[4 * rq] * rn, v[4 * rq + 1] * rn, v[4 * rq + 2] * rn, v[4 * rq + 3] * rn); }
#pragma unroll
      for (int i = 0; i < 8; ++i) { const int ch_ = i * 64 + lane, row = ch_ >> 4, ch = ch_ & 15; const int e = 128 * eh + 64 * half + 4 * ch;
        const float4 y = *(const float4*)(stg + row * 272 + ch * 16);
        const unsigned long long gg = *(const unsigned long long*)(PROJ + (grow0 + row) * LD + CG + h * 256 + e); const float4 gv = *(const float4*)(gn + h * 256 + e);
        const unsigned glo = (unsigned)gg, ghi = (unsigned)(gg >> 32);
        const float y0 = y.x * gv.x * __uint_as_float(glo << 16), y1 = y.y * gv.y * __uint_as_float(glo & 0xffff0000u), y2 = y.z * gv.z * __uint_as_float(ghi << 16), y3 = y.w * gv.w * __uint_as_float(ghi & 0xffff0000u);
        *(unsigned long long*)(Obase + (grow0 + row) * ldo + h * 256 + e) = (unsigned long long)cvtpk(y0, y1) | ((unsigned long long)cvtpk(y2, y3) << 32); } } }
}
#undef PKF
#undef KSWZ
#undef SBAR
}

constexpr int NWAVES = 8;
constexpr int BATCH = 2, SEQ = 8192, DM = 1024, M = BATCH * SEQ, FF = 4096;
constexpr int EVEN_IN = 4608, EVEN_OUT = 2048, ODD_IN = 1536;
constexpr int C_QA = 0, C_KA = 512, C_VA = 1024, C_GA = 2048, C_QB = 3072, C_KB = 4096, C_VB = 4352;
constexpr int C_QC = 0, C_KC = 1024, C_VC = 1280;
constexpr int RCH = 128, NCH = SEQ / RCH;
constexpr float EPS = 1e-6f;
constexpr size_t MiB = 1u << 20;
constexpr size_t WS_CTL = 0, CTL_ZERO_BYTES = 64 * 1024;
constexpr size_t WS_TAB = 1 * MiB;
constexpr size_t WS_WIN0 = 2 * MiB, WS_WOUT0 = 11 * MiB, WS_WUP0 = 15 * MiB, WS_WDN0 = 23 * MiB, WS_WIN1 = 31 * MiB, WS_WOUT1 = 34 * MiB, WS_WUP1 = 36 * MiB, WS_WDN1 = 44 * MiB;
constexpr size_t WS_PART = 52 * MiB;
constexpr size_t WS_XN = 56 * MiB;
constexpr size_t WS_PROJ = 88 * MiB;
constexpr size_t WS_H = WS_PROJ, WS_PROJ1 = WS_PROJ, WS_O1 = WS_PROJ + 48 * MiB;
constexpr size_t WS_Q8 = WS_PROJ + 144 * MiB, WS_K8 = WS_Q8 + 16 * MiB;
constexpr size_t WS_V8T = WS_K8 + 4 * MiB;
constexpr size_t WS_END = WS_V8T + 4 * MiB;
static_assert(WS_END <= 256 * MiB, "ws map");
constexpr int CW_BAR = 1024;
constexpr int RING_OFF = 0, RING_BYTES = 131072;
constexpr int LDSCTL_OFF = RING_BYTES, MISC_OFF = LDSCTL_OFF + 320;
constexpr int XS_OFF = RING_BYTES + 1024;
constexpr int SB_OFF = XS_OFF + 4096;
constexpr int LDS_BYTES = 147456;
static_assert(MISC_OFF + 128 <= LDS_BYTES, "LDS map");

#define GAS __attribute__((address_space(1)))
#define LAS __attribute__((address_space(3)))
typedef unsigned short bf16;
typedef unsigned v4u __attribute__((ext_vector_type(4)));
typedef float f32x4 __attribute__((ext_vector_type(4)));
typedef GAS unsigned gu32;
#define RLX_AGENT __ATOMIC_RELAXED, __HIP_MEMORY_SCOPE_AGENT
#define LDS_WAIT() asm volatile("s_waitcnt lgkmcnt(0)" ::: "memory")
#define VM_WAIT() asm volatile("s_waitcnt vmcnt(0)" ::: "memory")
__device__ __forceinline__ unsigned f2bf(float f) { unsigned u = __builtin_bit_cast(unsigned, f); return (u + 0x7fffu + ((u >> 16) & 1u)) >> 16; }
__device__ __forceinline__ unsigned pk2(float lo, float hi) { return f2bf(lo) | (f2bf(hi) << 16); }
__device__ __forceinline__ float bf2f(unsigned u) { return __uint_as_float(u << 16); }
#define XB_TMO      128
#define XB_XCNT(j)  (256  + 64 * (j))
#define XB_XSUB(j)  (1280 + 64 * (j))
#define XB_XGEN(j)  (2304 + 64 * (j))
#define XB_TOP      3328
#define XB_TOPGEN   3392
#define XCD_BAR_WORDS 3456
#define XB_SPIN_CAP (1u << 18)

__device__ __forceinline__ unsigned xb_ld(unsigned* p)              { return __hip_atomic_load(p, __ATOMIC_RELAXED, __HIP_MEMORY_SCOPE_AGENT); }
__device__ __forceinline__ unsigned xb_add(unsigned* p, unsigned v) { return __hip_atomic_fetch_add(p, v, __ATOMIC_RELAXED, __HIP_MEMORY_SCOPE_AGENT); }
__device__ __forceinline__ unsigned xb_xcc_id() { return (unsigned)__builtin_amdgcn_s_getreg((3 << 11) | 20) & 0xFu; }
#define XB_SPIN(cond, bar) do { unsigned _sp = 0; while (cond) { __builtin_amdgcn_s_sleep(1); \
    if ((++_sp & 255u) == 0u) { if (xb_ld(&(bar)[XB_TMO])) break; if (_sp > XB_SPIN_CAP) { atomicAdd(&(bar)[XB_TMO], 1u); break; } } } } while (0)

struct XcdBarrier {
    int wave; unsigned* bar; unsigned x;
    volatile LAS unsigned* st;
};

__device__ __forceinline__ XcdBarrier xcd_barrier_post(unsigned* bar, volatile LAS unsigned* st, int wave) {
    XcdBarrier b; b.bar = bar; b.x = xb_xcc_id(); b.st = st; b.wave = wave;
    if (is_t0(wave)) (void)xb_add(&bar[XB_XCNT(b.x)], 1u);
    return b;
}
__device__ __forceinline__ void xcd_barrier_complete(unsigned* bar, unsigned x, unsigned& nloc, unsigned& nx) {
    const unsigned G = gridDim.x * gridDim.y * gridDim.z;
    unsigned sum, cnt, mine, sp = 0u;
    for (;;) {
        sum = 0u; cnt = 0u; mine = 0u;
#pragma unroll
        for (unsigned j = 0; j < 16; ++j) { const unsigned c = xb_ld(&bar[XB_XCNT(j)]); sum += c; cnt += (c > 0u) ? 1u : 0u; mine = (j == x) ? c : mine; }
        if (sum == G) break;
        __builtin_amdgcn_s_sleep(1);
        if ((++sp & 255u) == 0u) { if (xb_ld(&bar[XB_TMO])) break; if (sp > XB_SPIN_CAP) { atomicAdd(&bar[XB_TMO], 1u); break; } }
    }
    nloc = mine > 0u ? mine : 1u; nx = cnt > 0u ? cnt : 1u;
}

__device__ __forceinline__ void xcd_barrier(const XcdBarrier& b) {
    asm volatile("s_waitcnt vmcnt(0)" ::: "memory");
    __syncthreads();
    if (is_t0(b.wave)) {
        unsigned* bar = b.bar;
        __builtin_amdgcn_s_waitcnt(0);
        unsigned nloc = b.st[0], nx = b.st[1];
        if (nloc == 0u) { xcd_barrier_complete(bar, b.x, nloc, nx); b.st[0] = nloc; b.st[1] = nx; }
        const unsigned old = xb_add(&bar[XB_XSUB(b.x)], 1u);
        const unsigned gen = old / nloc;
        if (old + 1u == (gen + 1u) * nloc) {
            __builtin_amdgcn_fence(__ATOMIC_RELEASE, "agent");
            asm volatile("s_waitcnt vmcnt(0)" ::: "memory");
            const unsigned og = xb_add(&bar[XB_TOP], 1u);
            const unsigned tg = og / nx;
            if (og + 1u == (tg + 1u) * nx) xb_add(&bar[XB_TOPGEN], 1u);
            else XB_SPIN(xb_ld(&bar[XB_TOPGEN]) == tg, bar);
            __builtin_amdgcn_fence(__ATOMIC_ACQUIRE, "agent");
            xb_add(&bar[XB_XGEN(b.x)], 1u);
            asm volatile("s_waitcnt vmcnt(0)" ::: "memory");
        } else {
            XB_SPIN(xb_ld(&bar[XB_XGEN(b.x)]) == gen, bar);
            __builtin_amdgcn_fence(__ATOMIC_ACQUIRE, "agent");
            asm volatile("s_waitcnt vmcnt(0)" ::: "memory");
        }
    }
    __syncthreads();
}

struct Frame {
    LAS unsigned char* lds;
    volatile LAS unsigned* MISC;
    gu32* ctl;
    int wave;
    int vcu, G;
};
__device__ __forceinline__ float wave_sum(float v) {
#pragma unroll
    for (int o = 1; o < 64; o <<= 1) v += __shfl_xor(v, o);
    return v;
}
__device__ __forceinline__ float wave_max(float v) {
#pragma unroll
    for (int o = 1; o < 64; o <<= 1) v = fmaxf(v, __shfl_xor(v, o));
    return v;
}
__device__ __forceinline__ int perm_col(int n0, int pmode) {
    const int r = n0 & 255, b = n0 & ~255;
    if (pmode == 1) return b + 128 * ((r >> 6) & 1) + 64 * (r >> 7) + (r & 32);
    if (pmode == 2) return b + 128 * ((r >> 5) & 1) + 64 * (r >> 7) + 32 * ((r >> 6) & 1);
    return n0;
}
__device__ __forceinline__ void p0_transpose_item(const float* W, int K, int N, bf16* WT, LAS float* scr, int item, int lane, int pmode = 0, int plo = 0, int phi = 0, int plo2 = 0, int phi2 = 0) {
    const int nblk = N / 32, kb = item / nblk, nb = item % nblk, k0 = 64 * kb, n0 = 32 * nb;
    const int r0 = ((n0 >= plo && n0 < phi) || (n0 >= plo2 && n0 < phi2)) ? perm_col(n0, pmode) : n0;
#pragma unroll 8
    for (int i = 0; i < 32; ++i) { const int kk = 2 * i + (lane >> 5); scr[kk * 33 + (lane & 31)] = W[(size_t)(k0 + kk) * N + n0 + (lane & 31)]; }
    LDS_WAIT(); asm volatile("" ::: "memory");
    const int c = lane & 7;
#pragma unroll
    for (int j = 0; j < 4; ++j) { const int n = (lane >> 3) + 8 * j; const LAS float* s = scr + (8 * c) * 33 + n;
        v4u o; o.x = pk2(s[0 * 33], s[1 * 33]); o.y = pk2(s[2 * 33], s[3 * 33]); o.z = pk2(s[4 * 33], s[5 * 33]); o.w = pk2(s[6 * 33], s[7 * 33]);
        *(GAS v4u*)(WT + (size_t)(r0 + n) * K + k0 + 8 * c) = o; }
    LDS_WAIT(); asm volatile("" ::: "memory");
}
__device__ __forceinline__ void rms_row_to_bf16(int lane, const float* xrow, const float* g, bf16* orow) {
    const GAS f32x4* xr = (const GAS f32x4*)xrow + lane; const GAS f32x4* gr = (const GAS f32x4*)g + lane;
    f32x4 v[4]; float s = 0.f;
#pragma unroll
    for (int j = 0; j < 4; ++j) { v[j] = xr[64 * j]; s += (v[j].x * v[j].x + v[j].y * v[j].y) + (v[j].z * v[j].z + v[j].w * v[j].w); }
    const float rstd = 1.f / sqrtf(wave_sum(s) * (1.f / DM) + EPS);
    GAS unsigned long long* o8 = (GAS unsigned long long*)orow + lane;
#pragma unroll
    for (int j = 0; j < 4; ++j) { const f32x4 gg = gr[64 * j];
        o8[64 * j] = (unsigned long long)pk2(v[j].x * rstd * gg.x, v[j].y * rstd * gg.y) | ((unsigned long long)pk2(v[j].z * rstd * gg.z, v[j].w * rstd * gg.w) << 32); }
}
__device__ __forceinline__ int t5_bucket(int rel) {
    const int n = rel < 0 ? -rel : rel; int v;
    if (n < 8) v = n; else { int l = 2 + (31 - __builtin_clz((unsigned)(n * n))); v = l < 15 ? l : 15; }
    return (rel > 0 ? 16 : 0) + v;
}
__device__ __forceinline__ float log_sigmoid(float x) { return -log1pf(__expf(-x)); }

struct Ptrs {
    const float* in[17]; float* out; unsigned char* ws;
};

constexpr int I_IN0 = (DM / 64) * (EVEN_IN / 32), I_OUT0 = (EVEN_OUT / 64) * (DM / 32), I_UP = (DM / 64) * (FF / 32), I_DN = (FF / 64) * (DM / 32), I_IN1 = (DM / 64) * (ODD_IN / 32), I_OUT1 = (DM / 64) * (DM / 32);
template <int SET> __device__ __forceinline__ void convert_weights(Frame& F, const Ptrs& P, int gw, int ngw) {
    const int lane = lane_id_v();
    LAS float* scr = (LAS float*)(F.lds + RING_OFF + F.wave * 16384);
    unsigned char* ws = P.ws;
    constexpr int NIT = SET == 0 ? I_IN0 : SET == 1 ? I_OUT0 + I_UP + I_DN + I_IN1 : I_OUT1 + I_UP + I_DN;
    for (int it = gw; it < NIT; it += ngw) {
        int r = it;
        if (SET == 0) {
            p0_transpose_item(P.in[3], DM, EVEN_IN, (bf16*)(ws + WS_WIN0), scr, r, lane, 1, C_QA, C_VA, C_QB, C_VB);
        } else if (SET == 1) {
            if (r < I_OUT0) { p0_transpose_item(P.in[4], EVEN_OUT, DM, (bf16*)(ws + WS_WOUT0), scr, r, lane); continue; } r -= I_OUT0;
            if (r < I_UP) { p0_transpose_item(P.in[15], DM, FF, (bf16*)(ws + WS_WUP0), scr, r, lane); continue; } r -= I_UP;
            if (r < I_DN) { p0_transpose_item(P.in[16], FF, DM, (bf16*)(ws + WS_WDN0), scr, r, lane); continue; } r -= I_DN;
            p0_transpose_item(P.in[11], DM, ODD_IN, (bf16*)(ws + WS_WIN1), scr, r, lane, 2, C_QC, C_VC);
        } else {
            if (r < I_OUT1) { p0_transpose_item(P.in[12], DM, DM, (bf16*)(ws + WS_WOUT1), scr, r, lane); continue; } r -= I_OUT1;
            if (r < I_UP) { p0_transpose_item(P.in[15] + (size_t)DM * FF, DM, FF, (bf16*)(ws + WS_WUP1), scr, r, lane); continue; } r -= I_UP;
            p0_transpose_item(P.in[16] + (size_t)DM * FF, FF, DM, (bf16*)(ws + WS_WDN1), scr, r, lane);
        }
    }
}
template <int SET> __device__ __forceinline__ void idle_filler(Frame& F, const Ptrs& P, int nwg) {
    const int G = F.G, c = (int)blockIdx.x, rem = nwg % G;
    if (rem == 0) { convert_weights<SET>(F, P, c * NWAVES + F.wave, G * NWAVES); return; }
    if (c >= rem) convert_weights<SET>(F, P, (c - rem) * NWAVES + F.wave, (G - rem) * NWAVES);
}
__device__ __forceinline__ void p0_prologue(Frame& F, const Ptrs& P) {
    const int lane = lane_id_v(), tid = F.wave * 64 + lane;
    const int gw = F.vcu * NWAVES + F.wave, NGW = F.G * NWAVES;
    convert_weights<0>(F, P, gw, NGW);
    for (int m = gw; m < M; m += NGW) rms_row_to_bf16(lane, P.in[0] + (size_t)m * DM, P.in[1], (bf16*)(P.ws + WS_XN) + (size_t)m * DM);
}

constexpr int SWA_TAB_OFF = 69632;
__device__ __forceinline__ void swa_phase(Frame& F, const Ptrs& P, unsigned char* ldsg, bool dummy, int i_lo, int i_hi) {
    const int lane = lane_id_v(), tid = F.wave * 64 + lane;
    float* tab = (float*)(ldsg + SWA_TAB_OFF);
    for (int i = tid; i < 8 * adense::SWA_TABN; i += NWAVES * 64) { const int h = i / adense::SWA_TABN, rel = i % adense::SWA_TABN - 192, n = rel < 0 ? -rel : rel;
        tab[i] = (n <= 128) ? P.in[10][t5_bucket(rel) * 8 + h] * 1.4426950408889634f : -1e30f; }
    __syncthreads();
    const int UPW = (512 + F.G - 1) / F.G;
    for (int i = i_lo; i < i_hi && i < UPW; ++i) { const int u = F.vcu * UPW + i; if (__builtin_expect(u >= 512, 0)) break;
        const int bk = u >> 7, qblk = u & 127;
        adense::swa_unit<EVEN_IN, C_QB, C_KB, C_VB, SEQ>((unsigned short*)(P.ws + WS_PROJ), dummy ? (unsigned short*)(P.ws + WS_XN) : (unsigned short*)(P.ws + WS_PROJ) + C_QB, dummy ? DM : EVEN_IN, bk >> 1, bk & 1, qblk, P.in[9], tab, (char*)ldsg, F.wave); }
}
__device__ __forceinline__ void ret_u_phase(Frame& F, const Ptrs& P, unsigned char* ldsg) {
    bf16* Ust = (bf16*)P.out;
    for (int u = F.vcu; u < BATCH * 4 * NCH; u += F.G) {
        const int n = u & (NCH - 1), h = (u >> 6) & 3, b = u >> 8;
        const float lf2 = log_sigmoid(P.in[5][h]) * 1.4426950408889634f, lb2 = log_sigmoid(P.in[5][4 + h]) * 1.4426950408889634f;
        bf16* UF = Ust + ((size_t)((0 * 2 + b) * 4 + h) * NCH + n) * 32768; bf16* UB = Ust + ((size_t)((1 * 2 + b) * 4 + h) * NCH + n) * 32768;
        adense::ret_u_unit<EVEN_IN, C_KA, C_VA>((const unsigned short*)(P.ws + WS_PROJ), UF, UB, (long)b * SEQ + (long)n * RCH, h, lf2, lb2, (char*)ldsg, F.wave);
    }
    __syncthreads();
}
__device__ __forceinline__ void ret_scan_phase(Frame& F, const Ptrs& P) {
    const int lane = lane_id_v(), tid = F.wave * 64 + lane;
    bf16* Ust = (bf16*)P.out;
    for (int idx = F.vcu * 512 + tid; idx < 2 * 8 * 8192; idx += F.G * 512) {
        const int dir = idx >> 16, rem = idx & 65535, bh = rem >> 13, el = (rem & 8191) * 4, h = bh & 3;
        const float decay = __expf(128.f * log_sigmoid(P.in[5][dir * 4 + h]));
        unsigned long long* p = (unsigned long long*)(Ust + ((size_t)(dir * 8 + bh) * NCH + (dir ? NCH - 1 : 0)) * 32768 + el);
        const long step = dir ? -8192 : 8192;
        float s0 = 0.f, s1 = 0.f, s2 = 0.f, s3 = 0.f;
        for (int nn = 0; nn < NCH; nn += 8) {
            unsigned long long uu[8];
#pragma unroll
            for (int k = 0; k < 8; ++k) uu[k] = p[k * step];
#pragma unroll
            for (int k = 0; k < 8; ++k) { p[k * step] = (unsigned long long)pk2(s0, s1) | ((unsigned long long)pk2(s2, s3) << 32);
                const unsigned lo = (unsigned)uu[k], hi = (unsigned)(uu[k] >> 32);
                s0 = decay * s0 + __uint_as_float(lo << 16); s1 = decay * s1 + __uint_as_float(lo & 0xffff0000u); s2 = decay * s2 + __uint_as_float(hi << 16); s3 = decay * s3 + __uint_as_float(hi & 0xffff0000u); }
            p += 8 * step;
        }
    }
}
__device__ __forceinline__ void ret_o_phase(Frame& F, const Ptrs& P, unsigned char* ldsg, bool dummy) {
    const bf16* Ust = (const bf16*)P.out;
    for (int u = F.vcu; u < BATCH * 4 * NCH; u += F.G) {
        const int n = u & (NCH - 1), h = (u >> 6) & 3, b = u >> 8;
        const float lf2 = log_sigmoid(P.in[5][h]) * 1.4426950408889634f, lb2 = log_sigmoid(P.in[5][4 + h]) * 1.4426950408889634f;
        const bf16* PF = Ust + ((size_t)((0 * 2 + b) * 4 + h) * NCH + n) * 32768; const bf16* PB = Ust + ((size_t)((1 * 2 + b) * 4 + h) * NCH + n) * 32768;
        adense::ret_o_unit<EVEN_IN, C_QA, C_KA, C_VA, C_GA>((unsigned short*)(P.ws + WS_PROJ), dummy ? (unsigned short*)(P.ws + WS_XN) : (unsigned short*)(P.ws + WS_PROJ) + C_GA, dummy ? DM : EVEN_IN, PF, PB, P.in[6], (long)b * SEQ + (long)n * RCH, h, lf2, lb2, (char*)ldsg, F.wave);
    }
    __syncthreads();
}

struct Args { Ptrs p; int ph_lo, ph_hi; };
__global__ void __launch_bounds__(NWAVES * 64, 2) mega_fwd(Args args) {
    extern __shared__ __attribute__((aligned(16))) unsigned char lds[];
    Frame F;
    F.lds = (LAS unsigned char*)lds;
    F.MISC = (volatile LAS unsigned*)(F.lds + MISC_OFF);
    F.wave = __builtin_amdgcn_readfirstlane((int)threadIdx.x >> 6);
    F.G = gridDim.x; { const int bx = blockIdx.x; F.vcu = (F.G % 8 == 0) ? (bx % 8) * (F.G / 8) + bx / 8 : bx; }
    const Ptrs& P = args.p;
    unsigned char* ws = P.ws;
    F.ctl = (gu32*)(ws + WS_CTL);
    for (int u = F.wave * 64 + lane_id_v(); u < (LDS_BYTES - LDSCTL_OFF) / 4; u += NWAVES * 64) ((LAS unsigned*)(F.lds + LDSCTL_OFF))[u] = 0u;
    __syncthreads();
    XcdBarrier bar = xcd_barrier_post((unsigned*)(F.ctl + CW_BAR), F.MISC + 8, F.wave);
#define GRID_BAR() xcd_barrier(bar)
    bf16* XN = (bf16*)(ws + WS_XN); bf16* PROJ = (bf16*)(ws + WS_PROJ); bf16* HB = (bf16*)(ws + WS_H); bf16* PROJ1 = (bf16*)(ws + WS_PROJ1); bf16* O1 = (bf16*)(ws + WS_O1);
    float* PART0 = (float*)(ws + WS_PART); float* PART1 = PART0 + (size_t)M * 16; float* PART2 = PART1 + (size_t)M * 16;
    const float* x = P.in[0];

    p0_prologue(F, P);
    GRID_BAR();
    { pg8::Gemm g{XN, (const bf16*)(ws + WS_WIN0), M, EVEN_IN, DM, DM}; pg8::StaticOrder S; S.init(M, EVEN_IN, F.G, (int)blockIdx.x);
      pg8::EpiProj E{PROJ, EVEN_IN, nullptr, (LAS float*)(F.lds + XS_OFF), 0, P.in[7], P.in[8], nullptr, nullptr, nullptr};
      pg8::gemm_phase<pg8::EpiProj, pg8::StaticOrder, true, true>(F.lds + RING_OFF, g, S, E, F.wave); }
    idle_filler<1>(F, P, (M / 256) * (EVEN_IN / 256)); GRID_BAR();
    { const int swa_half = (512 + F.G - 1) / F.G / 2;
#pragma nounroll
      for (int st = 0; st < 2; ++st) { if ((st == 0) == ((F.vcu & 1) != 0)) swa_phase(F, P, lds, false, 0, swa_half); else ret_u_phase(F, P, lds); } }
    GRID_BAR();
    ret_scan_phase(F, P); GRID_BAR();
    { const int swa_half = (512 + F.G - 1) / F.G / 2;
#pragma nounroll
      for (int st = 0; st < 2; ++st) { if ((st == 0) == ((F.vcu & 1) != 0)) ret_o_phase(F, P, lds, false); else swa_phase(F, P, lds, false, swa_half, 1 << 20); } }
    GRID_BAR();
    { pg8::Gemm g{PROJ + C_GA, (const bf16*)(ws + WS_WOUT0), M, DM, EVEN_OUT, EVEN_IN}; pg8::StaticOrder S; S.init(M, DM, F.G, (int)blockIdx.x);
      pg8::EpiRes<0> E{x, nullptr, nullptr, nullptr, XN, P.in[2], PART0, nullptr};
      pg8::gemm_phase<pg8::EpiRes<0>, pg8::StaticOrder, true, true>(F.lds + RING_OFF, g, S, E, F.wave); GRID_BAR(); }
    { pg8::Gemm g{XN, (const bf16*)(ws + WS_WUP0), M, FF, DM, DM}; pg8::StaticOrder S; S.init(M, FF, F.G, (int)blockIdx.x);
      pg8::EpiBf<2> E{HB, FF, nullptr};
      pg8::gemm_phase<pg8::EpiBf<2>, pg8::StaticOrder, true, true>(F.lds + RING_OFF, g, S, E, F.wave); GRID_BAR(); }
    { pg8::Gemm g{HB, (const bf16*)(ws + WS_WDN0), M, DM, FF, FF}; pg8::StaticOrder S; S.init(M, DM, F.G, (int)blockIdx.x);
      pg8::EpiRes<1> E{nullptr, XN, P.in[2], nullptr, XN, P.in[1] + DM, PART1, PART0};
      pg8::gemm_phase<pg8::EpiRes<1>, pg8::StaticOrder, true, true>(F.lds + RING_OFF, g, S, E, F.wave); GRID_BAR(); }
    { pg8::Gemm g{XN, (const bf16*)(ws + WS_WIN1), M, ODD_IN, DM, DM}; pg8::StaticOrder S; S.init(M, ODD_IN, F.G, (int)blockIdx.x);
      pg8::EpiProj E{PROJ1, ODD_IN, PART1, (LAS float*)(F.lds + XS_OFF), 1, P.in[13], P.in[14], ws + WS_Q8, ws + WS_K8, ws + WS_V8T};
      pg8::gemm_phase<pg8::EpiProj, pg8::StaticOrder, true, true>(F.lds + RING_OFF, g, S, E, F.wave); }
    idle_filler<2>(F, P, (M / 256) * (ODD_IN / 256)); GRID_BAR();
    { const int UPW = (512 + F.G - 1) / F.G;
      volatile LAS float* sbp = (volatile LAS float*)(F.lds + SB_OFF);
      { float mq = 0.f, mk = 0.f; for (int i = 0; i < 128; ++i) { mq = fmaxf(mq, fabsf(P.in[13][i])); mk = fmaxf(mk, fabsf(P.in[14][i])); }
        const float sbound = 128.f * mq * mk * (0.08838834764831845f * 1.4426950408889634f) * 1.02f + 0.5f;
        __syncthreads(); if (F.wave == 0 && lane_id_v() == 0) *sbp = sbound; __syncthreads(); }
      const bool fixed_ref = __builtin_amdgcn_readfirstlane((int)(*sbp < 60.f)) != 0;
#define ATTN_UNITS(...) for (int i = 0; i < UPW; ++i) { const int u = F.vcu * UPW + i; if (__builtin_expect(u >= 512, 0)) break; \
          const int bk = u >> 7, rem = u & 127, gq = rem >> 5, qb = rem & 31, b = bk >> 1, kvh = bk & 1, hq = kvh * 4 + gq; \
          const adense::bf16* Qb = (const adense::bf16*)(PROJ1 + (size_t)(b * SEQ + qb * 256) * ODD_IN + C_QC + hq * 128); \
          const adense::bf16* Kh = (const adense::bf16*)(PROJ1 + (size_t)(b * SEQ) * ODD_IN + C_KC + kvh * 128); \
          const adense::bf16* Vh = (const adense::bf16*)(PROJ1 + (size_t)(b * SEQ) * ODD_IN + C_VC + kvh * 128); \
          unsigned short* Oo = O1 + (size_t)(b * SEQ + qb * 256) * DM + hq * 128; __VA_ARGS__; }
      if (__builtin_expect(fixed_ref, 1)) { ATTN_UNITS(adense::attn_dense_body10_f8<DM, SEQ / 64>(ws + WS_Q8 + (size_t)(b * SEQ + qb * 256) * 1024 + hq * 128, ws + WS_K8 + (size_t)(b * SEQ) * 256 + kvh * 128, ws + WS_V8T + (size_t)(b * 2 + kvh) * 128 * 8192, Oo, (char*)lds + RING_OFF, F.lds + RING_OFF, F.wave)) }
      else { ATTN_UNITS((adense::attn_dense_body3_n<ODD_IN, ODD_IN, DM>(Qb, Kh, Vh, Oo, SEQ, (char*)lds + RING_OFF, F.wave))) }
#undef ATTN_UNITS
      GRID_BAR(); }
    { pg8::Gemm g{O1, (const bf16*)(ws + WS_WOUT1), M, DM, DM, DM}; pg8::StaticOrder S; S.init(M, DM, F.G, (int)blockIdx.x);
      pg8::EpiRes<1> E{nullptr, XN, P.in[1] + DM, nullptr, XN, P.in[2] + DM, PART2, nullptr};
      pg8::gemm_phase<pg8::EpiRes<1>, pg8::StaticOrder, true, true>(F.lds + RING_OFF, g, S, E, F.wave); GRID_BAR(); }
    { pg8::Gemm g{XN, (const bf16*)(ws + WS_WUP1), M, FF, DM, DM}; pg8::StaticOrder S; S.init(M, FF, F.G, (int)blockIdx.x);
      pg8::EpiBf<2> E{HB, FF, nullptr};
      pg8::gemm_phase<pg8::EpiBf<2>, pg8::StaticOrder, true, true>(F.lds + RING_OFF, g, S, E, F.wave); GRID_BAR(); }
    { pg8::Gemm g{HB, (const bf16*)(ws + WS_WDN1), M, DM, FF, FF}; pg8::StaticOrder S; S.init(M, DM, F.G, (int)blockIdx.x);
      pg8::EpiRes<2> E{nullptr, XN, P.in[2] + DM, P.out, nullptr, nullptr, nullptr, PART2};
      pg8::gemm_phase<pg8::EpiRes<2>, pg8::StaticOrder, true, true>(F.lds + RING_OFF, g, S, E, F.wave); }
}

extern "C" void kernel_launch(void* const* d_in, const int* in_sizes, int n_in, void* d_out, int out_size, void* d_ws, size_t ws_size, hipStream_t stream) {
    static int grid = 0;
    if (grid == 0) {
        if (n_in != 17 || in_sizes[0] != M * DM || out_size != M * DM || ws_size < WS_END) { fprintf(stderr, "kernel_launch: shape mismatch (n_in %d, in0 %d, out %d, ws %zu)\n", n_in, n_in > 0 ? in_sizes[0] : -1, out_size, ws_size); grid = -1; return; }
        int dev = 0, cus = 0, per_cu = 0;
        if (hipGetDevice(&dev) != hipSuccess || hipDeviceGetAttribute(&cus, hipDeviceAttributeMultiprocessorCount, dev) != hipSuccess) { grid = -1; return; }
        if (hipFuncSetAttribute((const void*)mega_fwd, hipFuncAttributeMaxDynamicSharedMemorySize, LDS_BYTES) != hipSuccess) { fprintf(stderr, "kernel_launch: hipFuncSetAttribute failed\n"); grid = -1; return; }
        if (hipOccupancyMaxActiveBlocksPerMultiprocessor(&per_cu, (const void*)mega_fwd, NWAVES * 64, LDS_BYTES) != hipSuccess || per_cu < 1) { fprintf(stderr, "kernel_launch: occupancy query reports %d blocks per CU\n", per_cu); (void)hipGetLastError(); grid = -1; return; }
        grid = cus;
    }
    if (grid < 0) return;
    if (hipMemsetAsync((char*)d_ws + WS_CTL, 0, CTL_ZERO_BYTES, stream) != hipSuccess) { fprintf(stderr, "kernel_launch: memset failed\n"); return; }
    Args a{};
    for (int i = 0; i < 17; ++i) a.p.in[i] = (const float*)d_in[i];
    a.p.out = (float*)d_out; a.p.ws = (unsigned char*)d_ws; a.ph_lo = 0; a.ph_hi = 0;
    hipLaunchKernelGGL(mega_fwd, dim3(grid), dim3(NWAVES * 64), LDS_BYTES, stream, a);
    const hipError_t le = hipPeekAtLastError();
    if (le != hipSuccess) fprintf(stderr, "kernel_launch: launch failed: %s\n", hipGetErrorName(le));
}
```

```cpp
#include <hip/hip_runtime.h>
#include <hip/hip_bf16.h>
#include <cstdio>
#include <cstdint>
#include <cmath>
__device__ __forceinline__ int lane_id_v() { int l; asm volatile("v_mbcnt_lo_u32_b32 %0, -1, 0\n\tv_mbcnt_hi_u32_b32 %0, -1, %0" : "=v"(l)); return l; }
__device__ __forceinline__ bool is_t0(int wave) { return wave == 0 && lane_id_v() == 0; }
namespace pg8 {
#define PG8_LAS __attribute__((address_space(3)))
typedef unsigned short bf16_t;
typedef short bf16x8 __attribute__((ext_vector_type(8)));
typedef float f32x4 __attribute__((ext_vector_type(4)));
typedef unsigned u32x4 __attribute__((ext_vector_type(4)));
typedef unsigned u32x2 __attribute__((ext_vector_type(2)));
constexpr int BM = 256, BK = 64, HALF = 128, HTB = HALF * BK * 2  , STAGE_BYTES = 8 * HTB, NXCD = 8, WGM = 8;

__host__ __device__ __forceinline__ int lds_byte(int r, int c) { const int st = (r >> 4) * 2 + (c >> 5), rr = r & 15, cc = c & 31, ob = rr * 64 + cc * 2; return st * 1024 + (ob ^ (((ob >> 9) & 1) << 5)); }
__host__ __device__ __forceinline__ void stage_rc(int b, int& R, int& C) { const int st = b / 1024, sb = b % 1024, swz = sb ^ (((sb >> 9) & 1) << 5); R = (st >> 1) * 16 + swz / 64; C = (st & 1) * 32 + (swz % 64) / 2; }
__host__ __device__ __forceinline__ int perm32(int rho) { const int n = rho >> 4, i = rho & 15; return 8 * (i >> 2) + 4 * n + (i & 3); }

struct Unit { int pm, pn; };
struct Gemm { const bf16_t* A; const bf16_t* Bt; int M, N, K, lda; };

struct StaticOrder {
    int nM, nN, nwg, G, c;
    __host__ __device__ void init(int M, int N, int G_, int c_) { nM = M / BM; nN = N / BM; nwg = nM * nN; G = G_; c = c_; }
    __host__ __device__ bool next(int i, Unit& u) const {
        const long L = (long)i * G + c; if (L >= nwg) return false;
        int wgid = (int)L; { const int q = nwg / NXCD, r = nwg % NXCD, xcd = wgid % NXCD, off = wgid / NXCD; wgid = (xcd < r ? xcd * (q + 1) : r * (q + 1) + (xcd - r) * q) + off; }
        const int nig = WGM * nN, gid = wgid / nig, fm = gid * WGM, gsz = (nM - fm) < WGM ? (nM - fm) : WGM;
        u.pm = fm + ((wgid % nig) % gsz); u.pn = (wgid % nig) / gsz; return true;
    }
    __device__ __forceinline__ void a_ready(const Unit&) const {}
    __device__ __forceinline__ void done(const Unit&) const {}
};

__device__ __forceinline__ unsigned cvt_pk_bf16(float lo, float hi) { unsigned r; asm volatile("v_cvt_pk_bf16_f32 %0, %1, %2" : "=v"(r) : "v"(lo), "v"(hi)); return r; }
constexpr float RMS_EPS = 1e-6f;
__device__ __forceinline__ float row_rs(const float* part, int row) {
    const f32x4* p = (const f32x4*)(part + (size_t)row * 16);
    const f32x4 a = p[0], b = p[1], c = p[2], d = p[3];
    const float s = ((a[0] + a[1]) + (a[2] + a[3])) + ((b[0] + b[1]) + (b[2] + b[3])) + ((c[0] + c[1]) + (c[2] + c[3])) + ((d[0] + d[1]) + (d[2] + d[3]));
    return __builtin_amdgcn_rsqf(s * (1.0f / 1024.0f) + RMS_EPS);
}
template <int ACT> struct EpiBf {
    static constexpr bool PERM = true, AFTER_DRAIN = false;
    bf16_t* O; int ldc; const float* part;
    __device__ __forceinline__ void operator()(const f32x4 (&acc)[2][2][4][2], const Unit& u, int wr, int wc, int fr, int fq) const {
        const int row0 = u.pm * BM + wr * 64 + fr, col0 = u.pn * BM + wc * 32 + 8 * fq;
#pragma unroll
        for (int ai = 0; ai < 2; ++ai)
#pragma unroll
            for (int m = 0; m < 4; ++m) { const int row = row0 + ai * HALF + m * 16; bf16_t* rowp = O + (size_t)row * ldc + col0;
                const float sc = part ? row_rs(part, row) : 1.0f;
#pragma unroll
                for (int bj = 0; bj < 2; ++bj) { f32x4 v0 = acc[ai][bj][m][0] * sc, v1 = acc[ai][bj][m][1] * sc;
                    if (ACT == 2) {
#pragma unroll
                        for (int e = 0; e < 4; ++e) { const float a = fmaxf(v0[e], 0.f), b = fmaxf(v1[e], 0.f); v0[e] = a * a; v1[e] = b * b; } }
                    u32x4 w; w.x = cvt_pk_bf16(v0[0], v0[1]); w.y = cvt_pk_bf16(v0[2], v0[3]); w.z = cvt_pk_bf16(v1[0], v1[1]); w.w = cvt_pk_bf16(v1[2], v1[3]);
                    *(u32x4*)(rowp + bj * HALF) = w; } }
    }
};
template <int MODE> struct EpiRes {
    static constexpr bool PERM = false, AFTER_DRAIN = false;
    const float* basef; const bf16_t* baseb; const float* gprev; float* outf; bf16_t* xn; const float* g; float* part; const float* part_in;
    __device__ __forceinline__ void operator()(const f32x4 (&acc)[2][2][4][2], const Unit& u, int wr, int wc, int fr, int fq) const {
        const int row0 = u.pm * BM + wr * 64 + fr, col0 = u.pn * BM + wc * 32 + 4 * fq;
        f32x4 gv[2][2], gi[2][2];
#pragma unroll
        for (int bj = 0; bj < 2; ++bj)
#pragma unroll
            for (int n = 0; n < 2; ++n) {
                if (MODE != 2) gv[bj][n] = *(const f32x4*)(g + col0 + bj * HALF + n * 16);
                if (MODE != 0) { const f32x4 t = *(const f32x4*)(gprev + col0 + bj * HALF + n * 16); gi[bj][n] = (f32x4){1.0f / t[0], 1.0f / t[1], 1.0f / t[2], 1.0f / t[3]}; } }
#pragma unroll
        for (int ai = 0; ai < 2; ++ai)
#pragma unroll
            for (int m = 0; m < 4; ++m) { const int row = row0 + ai * HALF + m * 16; const size_t off = (size_t)row * 1024 + col0; float s = 0.f;
                float sc2 = 1.0f; if (part_in) { const float r_ = row_rs(part_in, row); sc2 = r_ * r_; }
#pragma unroll
                for (int bj = 0; bj < 2; ++bj)
#pragma unroll
                    for (int n = 0; n < 2; ++n) { const size_t o2 = off + bj * HALF + n * 16; f32x4 b;
                        if (MODE == 0) b = *(const f32x4*)(basef + o2);
                        else { const u32x2 w = *(const u32x2*)(baseb + o2);
                            b = (f32x4){__uint_as_float(w.x << 16), __uint_as_float(w.x & 0xffff0000u), __uint_as_float(w.y << 16), __uint_as_float(w.y & 0xffff0000u)} * gi[bj][n]; }
                        const f32x4 o = b + acc[ai][bj][m][n] * sc2;
                        if (MODE == 2) *(f32x4*)(outf + o2) = o;
                        else { s += (o[0] * o[0] + o[1] * o[1]) + (o[2] * o[2] + o[3] * o[3]); const f32x4 t = o * gv[bj][n];
                            u32x2 w; w.x = cvt_pk_bf16(t[0], t[1]); w.y = cvt_pk_bf16(t[2], t[3]); *(u32x2*)(xn + o2) = w; } }
                if (MODE != 2) { s += __shfl_xor(s, 16); s += __shfl_xor(s, 32); if (fq == 0) part[(size_t)row * 16 + u.pn * 4 + wc] = s; }
                if (m & 1) asm volatile("" ::: "memory"); }
    }
};
struct EpiProj {
    static constexpr bool PERM = true, AFTER_DRAIN = false;
    bf16_t* O; int ldc; const float* part; PG8_LAS float* xs; int layer; const float* gq; const float* gk; unsigned char* q8; unsigned char* k8; unsigned char* v8t;
    __device__ __forceinline__ void operator()(const f32x4 (&acc)[2][2][4][2], const Unit& u, int wr, int wc, int fr, int fq) const {
        const int pn = u.pn; int kind; const float* g;
        if (layer == 0) { kind = pn < 2 ? 1 : pn < 4 ? 2 : pn < 8 ? 0 : pn < 12 ? 3 : pn < 17 ? 4 : 0; g = pn < 16 ? gq : gk; }
        else { kind = pn < 5 ? 5 : 0; g = pn < 4 ? gq : gk; }
        const int row0 = u.pm * BM + wr * 64 + fr;
        const int head = wc >> 1, sub = wc & 1;
        int c0, c1, d0;
        if (kind == 0 || kind == 3) { c0 = wc * 32 + 8 * fq; c1 = c0 + HALF; d0 = 0; }
        else if (kind == 5) { d0 = 64 * sub + 8 * fq; c0 = 128 * head + d0; c1 = c0 + 32; }
        else { d0 = 32 * sub + 8 * fq; c0 = 128 * head + d0; c1 = c0 + 64; }
        const int dpair = (kind == 5) ? 32 : 64;
        f32x4 v[2][4][2][2];
#pragma unroll
        for (int ai = 0; ai < 2; ++ai)
#pragma unroll
            for (int m = 0; m < 4; ++m) { const float sc = part ? row_rs(part, row0 + ai * HALF + m * 16) : 1.0f;
#pragma unroll
                for (int bj = 0; bj < 2; ++bj)
#pragma unroll
                    for (int n = 0; n < 2; ++n) v[ai][m][bj][n] = acc[ai][bj][m][n] * sc; }
        if (kind >= 4) {
#pragma unroll
            for (int ai = 0; ai < 2; ++ai)
#pragma unroll
                for (int m = 0; m < 4; ++m) { float s = 0.f;
#pragma unroll
                    for (int bj = 0; bj < 2; ++bj)
#pragma unroll
                        for (int n = 0; n < 2; ++n) { const f32x4 x = v[ai][m][bj][n]; s += (x[0] * x[0] + x[1] * x[1]) + (x[2] * x[2] + x[3] * x[3]); }
                    s += __shfl_xor(s, 16); s += __shfl_xor(s, 32);
                    if (fq == 0) xs[(wr * 4 + wc) * 128 + (ai * 4 + m) * 16 + fr] = s; }
            asm volatile("s_waitcnt lgkmcnt(0)" ::: "memory"); __builtin_amdgcn_s_barrier(); asm volatile("" ::: "memory");
            f32x4 gv[2][2];
#pragma unroll
            for (int bj = 0; bj < 2; ++bj)
#pragma unroll
                for (int n = 0; n < 2; ++n) gv[bj][n] = *(const f32x4*)(g + d0 + bj * dpair + 4 * n);
#pragma unroll
            for (int ai = 0; ai < 2; ++ai)
#pragma unroll
                for (int m = 0; m < 4; ++m) { const int xi = (ai * 4 + m) * 16 + fr; const float tot = xs[(wr * 4 + wc) * 128 + xi] + xs[(wr * 4 + (wc ^ 1)) * 128 + xi];
                    const float rn = 1.0f / sqrtf(tot * (1.0f / 128.0f) + RMS_EPS);
#pragma unroll
                    for (int bj = 0; bj < 2; ++bj)
#pragma unroll
                        for (int n = 0; n < 2; ++n) v[ai][m][bj][n] = v[ai][m][bj][n] * rn * gv[bj][n]; }
        }
        if (kind == 1 || kind == 2 || kind == 5) {
            const float fstep = (kind == 5) ? (13.287712379549449f / 32.0f) : (13.287712379549449f / 64.0f);
            const int f0 = (kind == 5) ? 8 * fq : d0;
            float inv[8];
#pragma unroll
            for (int k = 0; k < 8; ++k) inv[k] = exp2f(-(float)(f0 + k) * fstep);
            const float osc = (kind == 2) ? 0.08838834764831845f : (kind == 5 && pn < 4) ? (0.08838834764831845f * 1.4426950408889634f) : 1.0f;
#pragma unroll
            for (int ai = 0; ai < 2; ++ai)
#pragma unroll
                for (int m = 0; m < 4; ++m) { const int t = (row0 + ai * HALF + m * 16) & 8191; const float pos = (float)((kind == 5) ? (sub ? (t & 63) : (t >> 6)) : t);
#pragma unroll
                    for (int n = 0; n < 2; ++n)
#pragma unroll
                        for (int i = 0; i < 4; ++i) { float rev = (pos * inv[4 * n + i]) * 0.15915494309189535f; rev -= rintf(rev);
                            const float sn = __builtin_amdgcn_sinf(rev), cs = __builtin_amdgcn_cosf(rev);
                            const float x1 = v[ai][m][0][n][i], x2 = v[ai][m][1][n][i];
                            v[ai][m][0][n][i] = (x1 * cs - x2 * sn) * osc; v[ai][m][1][n][i] = (x2 * cs + x1 * sn) * osc; } }
        }
        if (kind == 3) {
#pragma unroll
            for (int ai = 0; ai < 2; ++ai)
#pragma unroll
                for (int m = 0; m < 4; ++m)
#pragma unroll
                    for (int bj = 0; bj < 2; ++bj)
#pragma unroll
                        for (int n = 0; n < 2; ++n)
#pragma unroll
                            for (int i = 0; i < 4; ++i) { const float x = v[ai][m][bj][n][i]; v[ai][m][bj][n][i] = x * __builtin_amdgcn_rcpf(1.0f + __builtin_amdgcn_exp2f(-1.4426950408889634f * x)); }
        }
        if (layer == 1 && pn == 5 && v8t) {
            const int d0v = wc * 32 + 8 * fq, hv = (fr >> 2) & 1, odd = fr & 1;
#pragma unroll
            for (int ai = 0; ai < 2; ++ai)
#pragma unroll
                for (int m = 0; m < 4; ++m) { const int row = row0 + ai * HALF + m * 16; const int tile = (row & 8191) >> 6, bb = row >> 13;
                    const int jv = 16 * (m >> 1) + 8 * (m & 1) + 4 * (fr >> 3) + (fr & 2);
#pragma unroll
                    for (int bj = 0; bj < 2; ++bj) { float x[8], y[8];
#pragma unroll
                        for (int e = 0; e < 4; ++e) { x[e] = v[ai][m][bj][0][e]; x[4 + e] = v[ai][m][bj][1][e]; }
#pragma unroll
                        for (int e = 0; e < 8; ++e) y[e] = __shfl_xor(x[e], 1);
                        unsigned char* blk = v8t + ((size_t)((bb * 2 + bj) * 128 + tile) * 128 + d0v + 4 * odd) * 64 + hv * 32 + jv;
#pragma unroll
                        for (int e = 0; e < 4; ++e) { const float lo = odd ? y[4 + e] : x[e], hi_ = odd ? x[4 + e] : y[e];
                            const int w = __builtin_amdgcn_cvt_pk_fp8_f32(lo, hi_, 0, false); *(unsigned short*)(blk + e * 64) = (unsigned short)(w & 0xffff); } } }
        }
        if (kind == 5 && q8) {
            const float f8s = 1.0f; unsigned char* b8 = (pn < 4) ? q8 + (size_t)pn * BM : k8; const int ld8 = (pn < 4) ? 1024 : 256;
#pragma unroll
            for (int ai = 0; ai < 2; ++ai)
#pragma unroll
                for (int m = 0; m < 4; ++m) { unsigned char* rp = b8 + (size_t)(row0 + ai * HALF + m * 16) * ld8;
#pragma unroll
                    for (int bj = 0; bj < 2; ++bj) { const f32x4 a0 = v[ai][m][bj][0] * f8s, a1 = v[ai][m][bj][1] * f8s;
                        int w0 = __builtin_amdgcn_cvt_pk_fp8_f32(a0[0], a0[1], 0, false); w0 = __builtin_amdgcn_cvt_pk_fp8_f32(a0[2], a0[3], w0, true);
                        int w1 = __builtin_amdgcn_cvt_pk_fp8_f32(a1[0], a1[1], 0, false); w1 = __builtin_amdgcn_cvt_pk_fp8_f32(a1[2], a1[3], w1, true);
                        u32x2 w; w.x = (unsigned)w0; w.y = (unsigned)w1; *(u32x2*)(rp + (bj ? c1 : c0)) = w; } }
        }
#pragma unroll
        for (int ai = 0; ai < 2; ++ai)
#pragma unroll
            for (int m = 0; m < 4; ++m) { bf16_t* rowp = O + (size_t)(row0 + ai * HALF + m * 16) * ldc + pn * BM;
#pragma unroll
                for (int bj = 0; bj < 2; ++bj) { const f32x4 v0 = v[ai][m][bj][0], v1 = v[ai][m][bj][1];
                    u32x4 w; w.x = cvt_pk_bf16(v0[0], v0[1]); w.y = cvt_pk_bf16(v0[2], v0[3]); w.z = cvt_pk_bf16(v1[0], v1[1]); w.w = cvt_pk_bf16(v1[2], v1[3]);
                    *(u32x4*)(rowp + (bj ? c1 : c0)) = w; } }
    }
};

template <class Epi, class Sched, bool ALIGN_EPI = false, bool SP2 = false>
__device__ __forceinline__ void gemm_phase(PG8_LAS unsigned char* lds, const Gemm g, const Sched& S, const Epi& E, const int wave_s) {
    int tid_ = wave_s * 64 + lane_id_v();
    const int tid = tid_, wid = wave_s, lane = tid & 63, wr = wid >> 2, wc = wid & 3, fr = lane & 15, fq = lane >> 4;
    const int K = g.K, nt = K / BK;
    unsigned voffA[2], voffB[2];
#pragma unroll
    for (int i = 0; i < 2; ++i) { int R, C; stage_rc(tid * 16 + i * 8192, R, C); const int Rb = Epi::PERM ? ((R & ~31) + perm32(R & 31)) : R;
        voffA[i] = (unsigned)(R * g.lda + C) * 2u; voffB[i] = (unsigned)(Rb * K + C) * 2u; }
    const size_t kstep = (size_t)(BK * 2);
    const size_t hstep = (size_t)HALF * K * 2, hstepA = (size_t)HALF * g.lda * 2;
    const size_t tstep = 2 * hstep, tstepA = 2 * hstepA;
    const unsigned ldsw = (unsigned)wid * 1024u;
    const int aoff = lds_byte(wr * 64 + fr, fq * 8), boff = lds_byte(wc * 32 + fr, fq * 8);
#define PG8_SA(b, h) (((b) * 2 + (h)) * HTB)
#define PG8_SB(b, h) ((4 + (b) * 2 + (h)) * HTB)
#define PG8_STAGE(bufoff, gbase, voff) do { _Pragma("unroll") for (int _i = 0; _i < 2; ++_i) \
        __builtin_amdgcn_global_load_lds((const unsigned*)((const char*)(gbase) + (voff)[_i]), (PG8_LAS unsigned*)(lds + (bufoff) + ldsw + _i * 8192), 16, 0, 0); } while (0)
#define PG8_LDA(dst, b, h) do { _Pragma("unroll") for (int m = 0; m < 4; ++m) _Pragma("unroll") for (int k = 0; k < 2; ++k) dst[m][k] = *(const PG8_LAS bf16x8*)(lds + PG8_SA(b, h) + aoff + m * 2048 + k * 1024); } while (0)
#define PG8_LDB(dst, b, h) do { _Pragma("unroll") for (int n = 0; n < 2; ++n) _Pragma("unroll") for (int k = 0; k < 2; ++k) dst[n][k] = *(const PG8_LAS bf16x8*)(lds + PG8_SB(b, h) + boff + n * 2048 + k * 1024); } while (0)
#define PG8_MMA(ai, bj, At, Bt) do { __builtin_amdgcn_s_setprio(1); _Pragma("unroll") for (int m = 0; m < 4; ++m) _Pragma("unroll") for (int n = 0; n < 2; ++n) _Pragma("unroll") for (int k = 0; k < 2; ++k) \
        acc[ai][bj][m][n] = __builtin_amdgcn_mfma_f32_16x16x32_bf16(Bt[n][k], At[m][k], acc[ai][bj][m][n], 0, 0, 0); __builtin_amdgcn_s_setprio(0); } while (0)
#define PG8_WAIT_V(n) asm volatile("s_waitcnt vmcnt(" #n ")" ::: "memory")
#define PG8_WAIT_L(n) asm volatile("s_waitcnt lgkmcnt(" #n ")" ::: "memory")
#define PG8_BAR __builtin_amdgcn_s_barrier()
#define PG8_SCHED __builtin_amdgcn_sched_barrier(0)
    Unit cur, nxt; int ui = 0;
    if (!S.next(0, cur)) return;
    f32x4 acc[2][2][4][2];
#pragma unroll
    for (int a = 0; a < 2; ++a)
#pragma unroll
        for (int b = 0; b < 2; ++b)
#pragma unroll
            for (int m = 0; m < 4; ++m)
#pragma unroll
                for (int n = 0; n < 2; ++n) acc[a][b][m][n] = (f32x4){0.f, 0.f, 0.f, 0.f};
    bf16x8 At[4][2], B0[2][2], B1[2][2];
    const char* cA = (const char*)g.A + (size_t)cur.pm * tstepA; const char* cB = (const char*)g.Bt + (size_t)cur.pn * tstep;
    S.a_ready(cur);
    if constexpr (SP2) {
        PG8_STAGE(PG8_SB(0, 0), cB, voffB); PG8_STAGE(PG8_SB(0, 1), cB + hstep, voffB); PG8_STAGE(PG8_SA(0, 0), cA, voffA); PG8_STAGE(PG8_SA(0, 1), cA + hstepA, voffA);
        if (wr == 1) PG8_BAR;
        PG8_WAIT_V(2); PG8_BAR;
        PG8_STAGE(PG8_SB(1, 0), cB + kstep, voffB); PG8_STAGE(PG8_SA(1, 0), cA + kstep, voffA); PG8_STAGE(PG8_SB(1, 1), cB + hstep + kstep, voffB);
        PG8_WAIT_V(6); PG8_BAR;
    } else {
        PG8_STAGE(PG8_SB(0, 0), cB, voffB); PG8_STAGE(PG8_SA(0, 0), cA, voffA); PG8_STAGE(PG8_SB(0, 1), cB + hstep, voffB); PG8_STAGE(PG8_SA(0, 1), cA + hstepA, voffA);
        if (wr == 1) PG8_BAR;
        PG8_WAIT_V(4); PG8_BAR;
        PG8_STAGE(PG8_SB(1, 0), cB + kstep, voffB); PG8_STAGE(PG8_SA(1, 0), cA + kstep, voffA); PG8_STAGE(PG8_SB(1, 1), cB + hstep + kstep, voffB);
        PG8_WAIT_V(6); PG8_BAR;
    }
    for (;;) {
        const bool has_next = S.next(ui + 1, nxt);
        const char* nA = has_next ? (const char*)g.A + (size_t)nxt.pm * tstepA : cA; const char* nB = has_next ? (const char*)g.Bt + (size_t)nxt.pn * tstep : cB;
        for (int t = 0; t < nt; t += 2) {
            const bool last = (t == nt - 2);
            const char* a1 = cA + (size_t)(t + 1) * kstep;
            const char* a2 = last ? nA : cA + (size_t)(t + 2) * kstep; const char* b2 = last ? nB : cB + (size_t)(t + 2) * kstep;
            const char* a3 = a2 + kstep; const char* b3 = b2 + kstep;
            if (last && has_next) S.a_ready(nxt);
            if constexpr (SP2) {
            PG8_LDB(B0, 0, 0); PG8_LDB(B1, 0, 1); PG8_SCHED; PG8_LDA(At, 0, 0); PG8_STAGE(PG8_SA(1, 1), a1 + hstepA, voffA);
            PG8_WAIT_V(8); PG8_WAIT_L(0); PG8_BAR; PG8_MMA(0, 0, At, B0); PG8_MMA(0, 1, At, B1); PG8_BAR; PG8_SCHED;
            PG8_LDA(At, 0, 1); PG8_STAGE(PG8_SB(0, 0), b2, voffB); PG8_STAGE(PG8_SB(0, 1), b2 + hstep, voffB); PG8_STAGE(PG8_SA(0, 0), a2, voffA);
            PG8_WAIT_V(8); PG8_WAIT_L(0); PG8_BAR; PG8_MMA(1, 0, At, B0); PG8_MMA(1, 1, At, B1); PG8_BAR; PG8_SCHED;
            PG8_LDB(B0, 1, 0); PG8_LDB(B1, 1, 1); PG8_SCHED; PG8_LDA(At, 1, 0); PG8_STAGE(PG8_SA(0, 1), a2 + hstepA, voffA);
            PG8_WAIT_V(8); PG8_WAIT_L(0); PG8_BAR; PG8_MMA(0, 0, At, B0); PG8_MMA(0, 1, At, B1); PG8_BAR; PG8_SCHED;
            PG8_LDA(At, 1, 1); PG8_STAGE(PG8_SB(1, 0), b3, voffB); PG8_STAGE(PG8_SB(1, 1), b3 + hstep, voffB); PG8_STAGE(PG8_SA(1, 0), a3, voffA);
            PG8_WAIT_V(8); PG8_WAIT_L(0); PG8_BAR; PG8_MMA(1, 0, At, B0); PG8_MMA(1, 1, At, B1); PG8_BAR; PG8_SCHED;
            } else {
            PG8_LDB(B0, 0, 0); PG8_SCHED; PG8_LDA(At, 0, 0); PG8_STAGE(PG8_SA(1, 1), a1 + hstepA, voffA);
            PG8_WAIT_L(8); PG8_BAR; PG8_WAIT_L(0); PG8_MMA(0, 0, At, B0); PG8_BAR; PG8_SCHED;
            PG8_LDB(B1, 0, 1); PG8_STAGE(PG8_SB(0, 0), b2, voffB);
            PG8_BAR; PG8_WAIT_L(0); PG8_MMA(0, 1, At, B1); PG8_BAR;
            PG8_LDA(At, 0, 1); PG8_STAGE(PG8_SA(0, 0), a2, voffA);
            PG8_BAR; PG8_WAIT_L(0); PG8_MMA(1, 0, At, B0); PG8_BAR; PG8_SCHED;
            PG8_STAGE(PG8_SB(0, 1), b2 + hstep, voffB);
            PG8_WAIT_V(6); PG8_BAR; PG8_MMA(1, 1, At, B1); PG8_BAR;
            PG8_LDB(B0, 1, 0); PG8_SCHED; PG8_LDA(At, 1, 0); PG8_STAGE(PG8_SA(0, 1), a2 + hstepA, voffA);
            PG8_WAIT_L(8); PG8_BAR; PG8_WAIT_L(0); PG8_MMA(0, 0, At, B0); PG8_BAR; PG8_SCHED;
            PG8_LDB(B1, 1, 1); PG8_STAGE(PG8_SB(1, 0), b3, voffB);
            PG8_BAR; PG8_WAIT_L(0); PG8_MMA(0, 1, At, B1); PG8_BAR;
            PG8_LDA(At, 1, 1); PG8_STAGE(PG8_SA(1, 0), a3, voffA);
            PG8_BAR; PG8_WAIT_L(0); PG8_MMA(1, 0, At, B0); PG8_BAR; PG8_SCHED;
            PG8_STAGE(PG8_SB(1, 1), b3 + hstep, voffB);
            PG8_WAIT_V(6); PG8_BAR; PG8_MMA(1, 1, At, B1); PG8_BAR;
            }
        }
        if constexpr (ALIGN_EPI) { if (wr == 0) PG8_BAR; }
        if constexpr (!Epi::AFTER_DRAIN) { E(acc, cur, wr, wc, fr, fq); S.done(cur); }
        if (!has_next) break;
#pragma unroll
        for (int a = 0; a < 2; ++a)
#pragma unroll
            for (int b = 0; b < 2; ++b)
#pragma unroll
                for (int m = 0; m < 4; ++m)
#pragma unroll
                    for (int n = 0; n < 2; ++n) acc[a][b][m][n] = (f32x4){0.f, 0.f, 0.f, 0.f};
        cur = nxt; cA = nA; cB = nB; ++ui;
        if constexpr (ALIGN_EPI) { if (wr == 1) PG8_BAR; }
    }
    PG8_WAIT_V(0);
    if constexpr (!ALIGN_EPI) { if (wr == 0) PG8_BAR; }
    PG8_BAR;
    if constexpr (Epi::AFTER_DRAIN) { E.fused(acc, cur, wr, wc, fr, fq, lds, wid, lane); S.done(cur); }
#undef PG8_SA
#undef PG8_SB
#undef PG8_STAGE
#undef PG8_LDA
#undef PG8_LDB
#undef PG8_MMA
#undef PG8_WAIT_V
#undef PG8_WAIT_L
#undef PG8_BAR
#undef PG8_SCHED
}
}
namespace adense {
using bf16 = __hip_bfloat16;
constexpr int D = 128, NW = 8, QBLK = 32, KVBLK = 64;
constexpr float SCALE = 0.088388347648318440f;
constexpr float THR = 8.f;
constexpr size_t SHM_V = KVBLK * D * 2, SHM_K = KVBLK * D * 2, SHM_ATTN = 2 * SHM_V + 2 * SHM_K + NW * 64 * 4;
using bf16x8 = __attribute__((ext_vector_type(8))) short;
using s16x4  = __attribute__((ext_vector_type(4))) short;
using f32x16 = __attribute__((ext_vector_type(16))) float;
using u32x4  = __attribute__((ext_vector_type(4))) unsigned;
#define KSWZ(row, colB) ((row) * 256 + ((colB) ^ ((((row) & 7) | ((((row) >> 4) & 1) << 3)) << 4)))
#define SBAR() __builtin_amdgcn_sched_barrier(0)
__device__ __forceinline__ int crow(int r, int hi) { return (r & 3) + 8 * (r >> 2) + 4 * hi; }
__device__ __forceinline__ unsigned cvtpk(float lo, float hi) { unsigned r; asm volatile("v_cvt_pk_bf16_f32 %0, %1, %2" : "=v"(r) : "v"(lo), "v"(hi)); return r; }
__device__ __forceinline__ bf16x8 ld8(const bf16* p) { return *reinterpret_cast<const bf16x8*>(p); }
typedef float f32x2_t __attribute__((ext_vector_type(2))); typedef __bf16 bf16x2_t __attribute__((ext_vector_type(2)));
__device__ __forceinline__ unsigned cvtpk_m(float lo, float hi) { f32x2_t v = {lo, hi}; bf16x2_t b = __builtin_convertvector(v, bf16x2_t); return __builtin_bit_cast(unsigned, b); }

__device__ __forceinline__ void partialSM(f32x16& p0, f32x16& p1, float& m_reg, float& mn, float& alpha) {
  constexpr float C = SCALE * 1.4426950408889634f;
  float pmax = p0[0]; for (int r = 1; r < 16; ++r) pmax = fmaxf(pmax, p0[r]); for (int r = 0; r < 16; ++r) pmax = fmaxf(pmax, p1[r]);
  { auto rr = __builtin_amdgcn_permlane32_swap(__float_as_uint(pmax), __float_as_uint(pmax), false, false);
    pmax = fmaxf(__uint_as_float(rr[0]), __uint_as_float(rr[1])); }
  if (__builtin_expect(__all(pmax - m_reg <= THR / SCALE), 1)) { mn = m_reg; alpha = 1.f; }
  else { mn = fmaxf(m_reg, pmax); alpha = __builtin_amdgcn_exp2f((m_reg - mn) * C); m_reg = mn; }
  float mnC = -mn * C;
  for (int r = 0; r < 16; ++r) p0[r] = fmaf(p0[r], C, mnC); for (int r = 0; r < 16; ++r) p1[r] = fmaf(p1[r], C, mnC);
  for (int r = 0; r < 16; ++r) p0[r] = __builtin_amdgcn_exp2f(p0[r]);
}
__device__ __forceinline__ void finishSM(f32x16& p0, f32x16& p1, float alpha, float& l_reg, bf16x8& pa0, bf16x8& pa1, bf16x8& pa2, bf16x8& pa3) {
  for (int r = 0; r < 16; ++r) p1[r] = __builtin_amdgcn_exp2f(p1[r]);
  float ps = 0; for (int r = 0; r < 16; ++r) ps += p0[r]; for (int r = 0; r < 16; ++r) ps += p1[r];
  { auto rr = __builtin_amdgcn_permlane32_swap(__float_as_uint(ps), __float_as_uint(ps), false, false);
    ps = __uint_as_float(rr[0]) + __uint_as_float(rr[1]); }
  l_reg = l_reg * alpha + ps;
#define PK4(P, BASE, OUT) do { unsigned a0 = cvtpk(P[BASE + 0], P[BASE + 1]), a1 = cvtpk(P[BASE + 2], P[BASE + 3]);   \
    unsigned b0 = cvtpk(P[BASE + 4], P[BASE + 5]), b1 = cvtpk(P[BASE + 6], P[BASE + 7]);                              \
    auto r0 = __builtin_amdgcn_permlane32_swap(a0, b0, false, false); auto r1 = __builtin_amdgcn_permlane32_swap(a1, b1, false, false); \
    u32x4 w = {r0[0], r1[0], r0[1], r1[1]}; OUT = *reinterpret_cast<bf16x8*>(&w); } while (0)
  PK4(p0, 0, pa0); PK4(p0, 8, pa1); PK4(p1, 0, pa2); PK4(p1, 8, pa3);
#undef PK4
}
__device__ __forceinline__ void qkt(f32x16& p0, f32x16& p1, const bf16* Ks, const bf16x8* qr, int r32, int hi) {
  p0 = f32x16{}; p1 = f32x16{};
  for (int d0 = 0; d0 < 8; ++d0) { int cb = (d0 * 16 + hi * 8) * 2;
    bf16x8 b0 = *reinterpret_cast<const bf16x8*>((const char*)Ks + KSWZ(r32, cb));
    bf16x8 b1 = *reinterpret_cast<const bf16x8*>((const char*)Ks + KSWZ(32 + r32, cb));
    p0 = __builtin_amdgcn_mfma_f32_32x32x16_bf16(b0, qr[d0], p0, 0, 0, 0);
    p1 = __builtin_amdgcn_mfma_f32_32x32x16_bf16(b1, qr[d0], p1, 0, 0, 0); }
}
__device__ __forceinline__ int v_st(int k, int c) { const int kk = (k & ~0xC) | ((k & 4) << 1) | ((k & 8) >> 1); return ((kk >> 3) * 4 + (c >> 5)) * 512 + ((kk & 7) * 32 + (c & 31)) * 2; }
__device__ __forceinline__ int v_rd_base(int lane) { return ((lane & 3) << 3) | (((lane >> 2) & 3) << 6) | (((lane >> 4) & 1) << 5) | (((lane >> 5) & 1) << 8); }
constexpr int v_rd_off(int d0, int ks, int half) { return d0 * 512 + ks * 4096 + half * 2048; }
template <int OFF> __device__ __forceinline__ s16x4 tr_read(int vb) {
  s16x4 r; asm volatile("ds_read_b64_tr_b16 %0, %1 offset:%2" : "=&v"(r) : "v"(vb), "i"(OFF) : "memory"); return r;
}
template <int D0> __device__ __forceinline__ void pv_one(f32x16& od, int vb, bf16x8 pa0, bf16x8 pa1, bf16x8 pa2, bf16x8 pa3) {
  const s16x4 l0 = tr_read<v_rd_off(D0, 0, 0)>(vb), h0 = tr_read<v_rd_off(D0, 0, 1)>(vb), l1 = tr_read<v_rd_off(D0, 1, 0)>(vb), h1 = tr_read<v_rd_off(D0, 1, 1)>(vb);
  const s16x4 l2 = tr_read<v_rd_off(D0, 2, 0)>(vb), h2 = tr_read<v_rd_off(D0, 2, 1)>(vb), l3 = tr_read<v_rd_off(D0, 3, 0)>(vb), h3 = tr_read<v_rd_off(D0, 3, 1)>(vb);
  asm volatile("s_waitcnt lgkmcnt(0)" ::: "memory"); SBAR();
#define PK(L, H) (bf16x8){L[0], L[1], L[2], L[3], H[0], H[1], H[2], H[3]}
  od = __builtin_amdgcn_mfma_f32_32x32x16_bf16(pa0, PK(l0, h0), od, 0, 0, 0);
  od = __builtin_amdgcn_mfma_f32_32x32x16_bf16(pa1, PK(l1, h1), od, 0, 0, 0);
  od = __builtin_amdgcn_mfma_f32_32x32x16_bf16(pa2, PK(l2, h2), od, 0, 0, 0);
  od = __builtin_amdgcn_mfma_f32_32x32x16_bf16(pa3, PK(l3, h3), od, 0, 0, 0);
#undef PK
}
__device__ __forceinline__ void pv_d0(f32x16* o, int vb, bf16x8 pa0, bf16x8 pa1, bf16x8 pa2, bf16x8 pa3) {
  pv_one<0>(o[0], vb, pa0, pa1, pa2, pa3); pv_one<1>(o[1], vb, pa0, pa1, pa2, pa3); pv_one<2>(o[2], vb, pa0, pa1, pa2, pa3); pv_one<3>(o[3], vb, pa0, pa1, pa2, pa3);
}
template <int D0> __device__ __forceinline__ void pv_one_lean(f32x16& od, int vb, bf16x8 pa0, bf16x8 pa1, bf16x8 pa2, bf16x8 pa3) {
#define PK(L, H) (bf16x8){L[0], L[1], L[2], L[3], H[0], H[1], H[2], H[3]}
  { const s16x4 l0 = tr_read<v_rd_off(D0, 0, 0)>(vb), h0 = tr_read<v_rd_off(D0, 0, 1)>(vb), l1 = tr_read<v_rd_off(D0, 1, 0)>(vb), h1 = tr_read<v_rd_off(D0, 1, 1)>(vb);
    asm volatile("s_waitcnt lgkmcnt(0)" ::: "memory"); SBAR();
    od = __builtin_amdgcn_mfma_f32_32x32x16_bf16(pa0, PK(l0, h0), od, 0, 0, 0); od = __builtin_amdgcn_mfma_f32_32x32x16_bf16(pa1, PK(l1, h1), od, 0, 0, 0); }
  { const s16x4 l2 = tr_read<v_rd_off(D0, 2, 0)>(vb), h2 = tr_read<v_rd_off(D0, 2, 1)>(vb), l3 = tr_read<v_rd_off(D0, 3, 0)>(vb), h3 = tr_read<v_rd_off(D0, 3, 1)>(vb);
    asm volatile("s_waitcnt lgkmcnt(0)" ::: "memory"); SBAR();
    od = __builtin_amdgcn_mfma_f32_32x32x16_bf16(pa2, PK(l2, h2), od, 0, 0, 0); od = __builtin_amdgcn_mfma_f32_32x32x16_bf16(pa3, PK(l3, h3), od, 0, 0, 0); }
#undef PK
}
__device__ __forceinline__ void pv_d0_lean(f32x16* o, int vb, bf16x8 pa0, bf16x8 pa1, bf16x8 pa2, bf16x8 pa3) {
  pv_one_lean<0>(o[0], vb, pa0, pa1, pa2, pa3); pv_one_lean<1>(o[1], vb, pa0, pa1, pa2, pa3); pv_one_lean<2>(o[2], vb, pa0, pa1, pa2, pa3); pv_one_lean<3>(o[3], vb, pa0, pa1, pa2, pa3);
}
#define PV_RD(X, D0) do { X[0] = tr_read<v_rd_off(D0, 0, 0)>(vb); X[1] = tr_read<v_rd_off(D0, 0, 1)>(vb); X[2] = tr_read<v_rd_off(D0, 1, 0)>(vb); X[3] = tr_read<v_rd_off(D0, 1, 1)>(vb); \
    X[4] = tr_read<v_rd_off(D0, 2, 0)>(vb); X[5] = tr_read<v_rd_off(D0, 2, 1)>(vb); X[6] = tr_read<v_rd_off(D0, 3, 0)>(vb); X[7] = tr_read<v_rd_off(D0, 3, 1)>(vb); } while (0)
#define PV_PK(L, H) (bf16x8){L[0], L[1], L[2], L[3], H[0], H[1], H[2], H[3]}
#define PV_MM(X, D0) do { o[D0] = __builtin_amdgcn_mfma_f32_32x32x16_bf16(pa0, PV_PK(X[0], X[1]), o[D0], 0, 0, 0); o[D0] = __builtin_amdgcn_mfma_f32_32x32x16_bf16(pa1, PV_PK(X[2], X[3]), o[D0], 0, 0, 0); \
    o[D0] = __builtin_amdgcn_mfma_f32_32x32x16_bf16(pa2, PV_PK(X[4], X[5]), o[D0], 0, 0, 0); o[D0] = __builtin_amdgcn_mfma_f32_32x32x16_bf16(pa3, PV_PK(X[6], X[7]), o[D0], 0, 0, 0); } while (0)
__device__ __forceinline__ void pv_d0p(f32x16* o, int vb, bf16x8 pa0, bf16x8 pa1, bf16x8 pa2, bf16x8 pa3) {
  s16x4 A[8], B[8];
  SBAR(); PV_RD(A, 0); PV_RD(B, 1);
  asm volatile("s_waitcnt lgkmcnt(8)" ::: "memory"); SBAR(); PV_MM(A, 0); SBAR();
  PV_RD(A, 2);
  asm volatile("s_waitcnt lgkmcnt(8)" ::: "memory"); SBAR(); PV_MM(B, 1); SBAR();
  PV_RD(B, 3);
  asm volatile("s_waitcnt lgkmcnt(8)" ::: "memory"); SBAR(); PV_MM(A, 2); SBAR();
  asm volatile("s_waitcnt lgkmcnt(0)" ::: "memory"); SBAR(); PV_MM(B, 3);
}


constexpr float THRL = 8.f;
__device__ __forceinline__ void qkt_n(f32x16& p0, f32x16& p1, const bf16* Ks, const bf16x8* qr, const f32x16& negm, int r32, int hi) {
#pragma unroll
  for (int d0 = 0; d0 < 8; ++d0) { int cb = (d0 * 16 + hi * 8) * 2;
    bf16x8 b0 = *reinterpret_cast<const bf16x8*>((const char*)Ks + KSWZ(r32, cb));
    bf16x8 b1 = *reinterpret_cast<const bf16x8*>((const char*)Ks + KSWZ(32 + r32, cb));
    if (d0 == 0) { p0 = __builtin_amdgcn_mfma_f32_32x32x16_bf16(b0, qr[0], negm, 0, 0, 0); p1 = __builtin_amdgcn_mfma_f32_32x32x16_bf16(b1, qr[0], negm, 0, 0, 0); }
    else { p0 = __builtin_amdgcn_mfma_f32_32x32x16_bf16(b0, qr[d0], p0, 0, 0, 0); p1 = __builtin_amdgcn_mfma_f32_32x32x16_bf16(b1, qr[d0], p1, 0, 0, 0); } }
}
template <bool FIRST> __device__ __forceinline__ void partialSM_n(f32x16& p0, f32x16& p1, float& mhat, f32x16& negm, float& alpha) {
  float pmax = p0[0]; for (int r = 1; r < 16; ++r) pmax = fmaxf(pmax, p0[r]); for (int r = 0; r < 16; ++r) pmax = fmaxf(pmax, p1[r]);
  { auto rr = __builtin_amdgcn_permlane32_swap(__float_as_uint(pmax), __float_as_uint(pmax), false, false);
    pmax = fmaxf(__uint_as_float(rr[0]), __uint_as_float(rr[1])); }
  if (!FIRST && __builtin_expect(__all(pmax <= THRL), 1)) { alpha = 1.f; }
  else { const float dl = FIRST ? pmax : fmaxf(pmax, 0.f); mhat += dl;
    for (int r = 0; r < 16; ++r) { p0[r] -= dl; p1[r] -= dl; }
    for (int r = 0; r < 16; ++r) negm[r] = -mhat;
    alpha = FIRST ? 1.f : __builtin_amdgcn_exp2f(-dl); }
  for (int r = 0; r < 16; ++r) p0[r] = __builtin_amdgcn_exp2f(p0[r]);
}
template <int LDQ, int LDK, int LDO>
__device__ __forceinline__ void attn_dense_body3_n(const bf16* __restrict__ Qb, const bf16* __restrict__ Kh, const bf16* __restrict__ Vh,
                                                 unsigned short* __restrict__ Ob, int seq, char* lds, const int wave_s) {
  int tid_ = wave_s * 64 + lane_id_v();
  const int tid = tid_, wid = wave_s, lane = tid & 63, r32 = lane & 31, hi = lane >> 5;
  constexpr int BUF = (int)(SHM_V + SHM_K);
  float* ws = (float*)(lds + 3 * BUF) + wid * 64; float* li_l = ws; float* al_l = ws + 32;
  float m_reg = 0.f, l_reg = 0; f32x16 o[4] = {}; bf16x8 qr[8]; f32x16 negm = {};
  const bf16* Qw = Qb + (long)(wid * QBLK + r32) * LDQ + hi * 8;
#pragma unroll
  for (int d0 = 0; d0 < 8; ++d0) qr[d0] = ld8(Qw + d0 * 16);
  const int sr = tid >> 4, sc = (tid & 15) * 8, vst0 = v_st(sr, sc), vst1 = v_st(32 + sr, sc);
  const int vb0 = (int)(uintptr_t)lds + v_rd_base(lane);
  bf16x8 s_v0, s_v1, s_k0, s_k1;
#define SLOAD(k0) do { s_v0 = ld8(&Vh[(long)((k0) + sr) * LDK + sc]); s_v1 = ld8(&Vh[(long)((k0) + 32 + sr) * LDK + sc]); \
    s_k0 = ld8(&Kh[(long)((k0) + sr) * LDK + sc]); s_k1 = ld8(&Kh[(long)((k0) + 32 + sr) * LDK + sc]); } while (0)
#define SWRITE(boff) do { char* b_ = lds + (boff); *(bf16x8*)(b_ + vst0) = s_v0; *(bf16x8*)(b_ + vst1) = s_v1; const int kc = sc * 2;  \
    *(bf16x8*)(b_ + SHM_V + KSWZ(sr, kc)) = s_k0; *(bf16x8*)(b_ + SHM_V + KSWZ(32 + sr, kc)) = s_k1; } while (0)
#define RESC(a) do { if (__any((a) < 1.f)) { if (hi == 0) al_l[r32] = (a); asm volatile("s_waitcnt lgkmcnt(0)" ::: "memory"); \
    for (int d = 0; d < 4; ++d) for (int r = 0; r < 16; ++r) o[d][r] *= al_l[crow(r, hi)]; } } while (0)
#define ROT() do { const int t_ = b0; b0 = b1; b1 = b2; b2 = t_; } while (0)
  f32x16 pA0, pA1, pB0, pB1; float mnA, mnB, alA, alB; bf16x8 pa0, pa1, pa2, pa3; const int NT = seq / KVBLK;
  int b0 = 2 * BUF, b1 = 0, b2 = BUF;
  SLOAD(0); SWRITE(0); SLOAD(KVBLK); __syncthreads();
  SWRITE(b2); if (2 < NT) SLOAD(2 * KVBLK); SBAR();
  qkt_n(pA0, pA1, (const bf16*)(lds + b1 + SHM_V), qr, negm, r32, hi); partialSM_n<true>(pA0, pA1, m_reg, negm, alA);
  __syncthreads(); ROT();
  for (int j = 1; j + 1 < NT; j += 2) {
    SWRITE(b2); if (j + 2 < NT) SLOAD((j + 2) * KVBLK); SBAR();
    qkt_n(pB0, pB1, (const bf16*)(lds + b1 + SHM_V), qr, negm, r32, hi);
    finishSM(pA0, pA1, alA, l_reg, pa0, pa1, pa2, pa3); SBAR();
    pv_d0_lean(o, vb0 + b0, pa0, pa1, pa2, pa3); partialSM_n<false>(pB0, pB1, m_reg, negm, alB);
    RESC(alB); __syncthreads(); ROT();
    if (j + 2 < NT) SWRITE(b2); if (j + 3 < NT) SLOAD((j + 3) * KVBLK); SBAR();
    qkt_n(pA0, pA1, (const bf16*)(lds + b1 + SHM_V), qr, negm, r32, hi);
    finishSM(pB0, pB1, alB, l_reg, pa0, pa1, pa2, pa3); SBAR();
    pv_d0_lean(o, vb0 + b0, pa0, pa1, pa2, pa3); partialSM_n<false>(pA0, pA1, m_reg, negm, alA);
    RESC(alA); __syncthreads(); ROT();
  }
  SBAR(); qkt_n(pB0, pB1, (const bf16*)(lds + b1 + SHM_V), qr, negm, r32, hi);
  finishSM(pA0, pA1, alA, l_reg, pa0, pa1, pa2, pa3); SBAR();
  const int vbt = (int)(uintptr_t)lds + v_rd_base(lane_id_v());
  pv_d0_lean(o, vbt + b0, pa0, pa1, pa2, pa3); partialSM_n<false>(pB0, pB1, m_reg, negm, alB);
  RESC(alB);
  finishSM(pB0, pB1, alB, l_reg, pa0, pa1, pa2, pa3); SBAR();
  pv_d0_lean(o, vbt + b1, pa0, pa1, pa2, pa3);
  const int lane_e = lane_id_v(), r32e = lane_e & 31, hie = lane_e >> 5; float* li_e = (float*)(lds + 3 * BUF) + wave_s * 64;
  if (hie == 0) li_e[r32e] = l_reg; asm volatile("s_waitcnt lgkmcnt(0)" ::: "memory");
  float rli[16];
#pragma unroll
  for (int r = 0; r < 16; ++r) rli[r] = __builtin_amdgcn_rcpf(li_e[crow(r, hie)]);
  unsigned short* Ow = Ob + (long)(wave_s * QBLK) * LDO;
#pragma unroll
  for (int r = 0; r < 16; ++r) { int orow = crow(r, hie);
    for (int d0 = 0; d0 < 4; ++d0) { const unsigned pk = cvtpk(o[d0][r] * rli[r], 0.f); Ow[(long)orow * LDO + d0 * 32 + r32e] = (unsigned short)(pk & 0xffffu); } }
  __syncthreads();
#undef SLOAD
#undef SWRITE
#undef RESC
#undef ROT
}
__device__ __forceinline__ int v_st_n(int k, int c) { return ((k >> 3) * 4 + (c >> 5)) * 512 + ((k & 7) * 32 + (c & 31)) * 2; }
typedef int v8i __attribute__((ext_vector_type(8)));
typedef short v2s __attribute__((ext_vector_type(2)));
#define K8OFF(row, colB) ((row) * 128 + ((colB) ^ ((((row) >> 1) & 7) << 4)))
#define V8OFF(d, colB) ((d) * 64 + ((colB) ^ ((((d) >> 2) & 3) << 4)))
#define PIN(x) asm volatile("" : "+v"(x))
__device__ __forceinline__ v8i k8frag(const char* Kt, int row, int colB) {
  const u32x4 lo = *(const u32x4*)(Kt + K8OFF(row, colB)), hi4 = *(const u32x4*)(Kt + K8OFF(row, colB + 16));
  return (v8i){(int)lo.x, (int)lo.y, (int)lo.z, (int)lo.w, (int)hi4.x, (int)hi4.y, (int)hi4.z, (int)hi4.w};
}
__device__ __forceinline__ v8i v8frag(const char* Vt, int d, int colB) {
  const u32x4 lo = *(const u32x4*)(Vt + V8OFF(d, colB)), hi4 = *(const u32x4*)(Vt + V8OFF(d, colB + 16));
  return (v8i){(int)lo.x, (int)lo.y, (int)lo.z, (int)lo.w, (int)hi4.x, (int)hi4.y, (int)hi4.z, (int)hi4.w};
}
__device__ __forceinline__ void finishSM_z(const f32x16& p0, f32x16& p1, float scl, v8i& P8) {
  for (int r = 0; r < 16; ++r) p1[r] = __builtin_amdgcn_exp2f(p1[r]);
#pragma unroll
  for (int k = 0; k < 4; ++k) { v2s w, u; asm volatile("" : "=v"(w)); asm volatile("" : "=v"(u));
    w = __builtin_amdgcn_cvt_scalef32_pk_fp8_f32(w, p0[4 * k], p0[4 * k + 1], scl, false); w = __builtin_amdgcn_cvt_scalef32_pk_fp8_f32(w, p0[4 * k + 2], p0[4 * k + 3], scl, true);
    u = __builtin_amdgcn_cvt_scalef32_pk_fp8_f32(u, p1[4 * k], p1[4 * k + 1], scl, false); u = __builtin_amdgcn_cvt_scalef32_pk_fp8_f32(u, p1[4 * k + 2], p1[4 * k + 3], scl, true);
    P8[k] = __builtin_bit_cast(int, w); P8[4 + k] = __builtin_bit_cast(int, u); }
  PIN(P8);
}
template <int LDO, int NT>
__device__ __forceinline__ void attn_dense_body10_f8(const unsigned char* __restrict__ Q8b, const unsigned char* __restrict__ K8h, const unsigned char* __restrict__ V8b,
                                                   unsigned short* __restrict__ Ob, char* lds, __attribute__((address_space(3))) unsigned char* ldsl, const int wave_s) {
  int tid_ = wave_s * 64 + lane_id_v();
  const int tid = tid_, wid = wave_s, lane = tid & 63, r32 = lane & 31, hi = lane >> 5;
  constexpr int BUF = 16384;
  float* ws = (float*)(lds + 6 * BUF) + wid * 64; float* al_l = ws + 32;
  float Ef = -1e30f, thr = -1e30f, scl = 1.f; f32x16 o[4] = {}, lacc = {};
  v8i qf[2], ones;
  { const unsigned char* Qw = Q8b + (long)(wid * QBLK + r32) * 1024 + hi * 32;
#pragma unroll
    for (int s = 0; s < 2; ++s) { const u32x4 lo = *(const u32x4*)(Qw + 64 * s), hi4 = *(const u32x4*)(Qw + 64 * s + 16); qf[s] = (v8i){(int)lo.x, (int)lo.y, (int)lo.z, (int)lo.w, (int)hi4.x, (int)hi4.y, (int)hi4.z, (int)hi4.w}; }
    for (int k = 0; k < 8; ++k) ones[k] = 0x38383838; PIN(ones); }
  const unsigned kgo = (unsigned)((tid >> 3) * 256 + (((tid & 7) ^ ((tid >> 4) & 7)) << 4));
  const unsigned vgo = (unsigned)((tid >> 2) * 64 + (((tid & 3) ^ ((tid >> 4) & 3)) << 4));
  const unsigned ldsw = (unsigned)wid * 1024u;
  constexpr int SA = 0, SB = 0, S1 = 0;
#define SDMA(k0, boff) do { \
    __builtin_amdgcn_global_load_lds((const unsigned*)(K8h + (long)(k0) * 256 + kgo), (__attribute__((address_space(3))) unsigned*)(ldsl + (boff) + 8192 + ldsw), 16, 0, 0); \
    __builtin_amdgcn_global_load_lds((const unsigned*)(V8b + (long)((k0) >> 6) * 8192 + vgo), (__attribute__((address_space(3))) unsigned*)(ldsl + (boff) + ldsw), 16, 0, 0); } while (0)
#define QK(P0, P1, boff) do { const char* Kt_ = lds + (boff) + 8192; const f32x16 z_ = {}; \
    const v8i a00 = k8frag(Kt_, r32, 32 * hi), a10 = k8frag(Kt_, 32 + r32, 32 * hi), a01 = k8frag(Kt_, r32, 64 + 32 * hi), a11 = k8frag(Kt_, 32 + r32, 64 + 32 * hi); \
    P0 = __builtin_amdgcn_mfma_scale_f32_32x32x64_f8f6f4(a00, qf[0], z_, 0, 0, 0, SA, 0, SB); P1 = __builtin_amdgcn_mfma_scale_f32_32x32x64_f8f6f4(a10, qf[0], z_, 0, 0, 0, SA, 0, SB); \
    P0 = __builtin_amdgcn_mfma_scale_f32_32x32x64_f8f6f4(a01, qf[1], P0, 0, 0, 0, SA, 0, SB); P1 = __builtin_amdgcn_mfma_scale_f32_32x32x64_f8f6f4(a11, qf[1], P1, 0, 0, 0, SA, 0, SB); } while (0)
#define PV(boff) do { const char* Vt_ = lds + (boff); \
    { const v8i b0_ = v8frag(Vt_, r32, 32 * hi), b1_ = v8frag(Vt_, 32 + r32, 32 * hi); \
      lacc = __builtin_amdgcn_mfma_scale_f32_32x32x64_f8f6f4(P8, ones, lacc, 0, 0, 0, S1, 0, S1); \
      o[0] = __builtin_amdgcn_mfma_scale_f32_32x32x64_f8f6f4(P8, b0_, o[0], 0, 0, 0, S1, 0, S1); o[1] = __builtin_amdgcn_mfma_scale_f32_32x32x64_f8f6f4(P8, b1_, o[1], 0, 0, 0, S1, 0, S1); } \
    { const v8i b2_ = v8frag(Vt_, 64 + r32, 32 * hi), b3_ = v8frag(Vt_, 96 + r32, 32 * hi); \
      o[2] = __builtin_amdgcn_mfma_scale_f32_32x32x64_f8f6f4(P8, b2_, o[2], 0, 0, 0, S1, 0, S1); o[3] = __builtin_amdgcn_mfma_scale_f32_32x32x64_f8f6f4(P8, b3_, o[3], 0, 0, 0, S1, 0, S1); } } while (0)
#define PARTMAX(P0, P1) do { pm = fmaxf(P0[0], P1[0]); for (int r_ = 1; r_ < 16; ++r_) pm = fmaxf(fmaxf(pm, P0[r_]), P1[r_]); \
    { auto rr_ = __builtin_amdgcn_permlane32_swap(__float_as_uint(pm), __float_as_uint(pm), false, false); pm = fmaxf(__uint_as_float(rr_[0]), __uint_as_float(rr_[1])); } \
    for (int r_ = 0; r_ < 16; ++r_) P0[r_] = __builtin_amdgcn_exp2f(P0[r_]); PIN(P0); PIN(pm); } while (0)
#define ADJ() do { if (__any(pm > thr)) { const float want_ = ceilf(pm - 7.f), En_ = (pm > thr) ? want_ : Ef; const float al_ = __builtin_amdgcn_exp2f(Ef - En_); \
      Ef = En_; thr = En_ + 8.f; scl = __int_as_float(((int)En_ + 127) << 23); \
      if (hi == 0) al_l[r32] = al_; asm volatile("s_waitcnt lgkmcnt(0)" ::: "memory"); \
      for (int r_ = 0; r_ < 16; ++r_) { const float f_ = al_l[crow(r_, hi)]; for (int d_ = 0; d_ < 4; ++d_) o[d_][r_] *= f_; lacc[r_] *= f_; } } } while (0)
#define PAIR_SYNC() do { asm volatile("s_waitcnt vmcnt(0)" ::: "memory"); __builtin_amdgcn_s_barrier(); } while (0)
#define STEP(PN0, PN1, PO0, PO1, BQ, BP) do { \
    SBAR(); QK(PN0, PN1, (BQ) * BUF); finishSM_z(PO0, PO1, scl, P8); PIN(PN0); PIN(PN1); SBAR(); \
    PV((BP) * BUF); PARTMAX(PN0, PN1); SBAR(); ADJ(); } while (0)
#define PAIR(B, T) do { SDMA(min((T) + 2, NT - 1) * KVBLK, (((B) + 2) % 6) * BUF); SDMA(min((T) + 3, NT - 1) * KVBLK, (((B) + 3) % 6) * BUF); \
    STEP(pB0, pB1, pA0, pA1, (B), ((B) + 5) % 6); STEP(pA0, pA1, pB0, pB1, ((B) + 1) % 6, (B)); PAIR_SYNC(); } while (0)
  f32x16 pA0, pA1, pB0, pB1; float pm; v8i P8;
  SDMA(0, 0); SDMA(KVBLK, BUF); SDMA(2 * KVBLK, 2 * BUF); PAIR_SYNC();
  SBAR(); QK(pA0, pA1, 0); PARTMAX(pA0, pA1); SBAR(); ADJ();
  static_assert((NT - 2) % 6 == 0, "tile count");
#pragma nounroll
  for (int j = 1; j + 1 < NT; j += 6) { PAIR(1, j); PAIR(3, j + 2); PAIR(5, j + 4); }
  SBAR(); QK(pB0, pB1, 1 * BUF); finishSM_z(pA0, pA1, scl, P8); PIN(pB0); PIN(pB1); SBAR();
  PV(0 * BUF); PARTMAX(pB0, pB1); SBAR(); ADJ();
  finishSM_z(pB0, pB1, scl, P8); SBAR();
  PV(1 * BUF);
  asm volatile("s_waitcnt vmcnt(0)" ::: "memory");
  const int lane_e = lane_id_v(), r32e = lane_e & 31, hie = lane_e >> 5;
  unsigned short* Ow = Ob + (long)(wave_s * QBLK) * LDO;
#pragma unroll
  for (int r = 0; r < 16; ++r) { const int orow = crow(r, hie); const float rl = __builtin_amdgcn_rcpf(lacc[r]);
    for (int d0 = 0; d0 < 4; ++d0) { const unsigned pk = cvtpk(o[d0][r] * rl, 0.f); Ow[(long)orow * LDO + d0 * 32 + r32e] = (unsigned short)(pk & 0xffffu); } }
  __syncthreads();
#undef SDMA
#undef QK
#undef PV
#undef PARTMAX
#undef ADJ
#undef PAIR_SYNC
#undef STEP
#undef PAIR
}
#undef V8OFF
#undef K8OFF
constexpr int SWA_TABN = 448;
constexpr float THR2 = 8.f;
__device__ __forceinline__ void partialSM_b(f32x16& p0, f32x16& p1, const float* tbj, float& m_reg, float& mn, float& alpha) {
  constexpr float C = SCALE * 1.4426950408889634f;
#pragma unroll
  for (int r = 0; r < 16; ++r) { const int o = (r & 3) + 8 * (r >> 2); p0[r] = fmaf(p0[r], C, tbj[o]); p1[r] = fmaf(p1[r], C, tbj[o + 32]); }
  float pmax = p0[0]; for (int r = 1; r < 16; ++r) pmax = fmaxf(pmax, p0[r]); for (int r = 0; r < 16; ++r) pmax = fmaxf(pmax, p1[r]);
  { auto rr = __builtin_amdgcn_permlane32_swap(__float_as_uint(pmax), __float_as_uint(pmax), false, false);
    pmax = fmaxf(__uint_as_float(rr[0]), __uint_as_float(rr[1])); }
  if (__builtin_expect(__all(pmax - m_reg <= THR2), 1)) { mn = m_reg; alpha = 1.f; }
  else { mn = fmaxf(m_reg, pmax); alpha = __builtin_amdgcn_exp2f(m_reg - mn); m_reg = mn; }
  for (int r = 0; r < 16; ++r) p0[r] -= mn; for (int r = 0; r < 16; ++r) p1[r] -= mn;
  for (int r = 0; r < 16; ++r) p0[r] = __builtin_amdgcn_exp2f(p0[r]);
}
template <int LD, int CQ, int CK, int CV, int SEQ_>
__device__ __forceinline__ void swa_unit(unsigned short* PROJ_, unsigned short* Obase, int ldo, int b, int kvh, int qblk, const float* sinkp, const float* tab, char* lds, const int wave_s) {
  int tid_ = wave_s * 64 + lane_id_v();
  const int tid = tid_, wid = wave_s, lane = tid & 63, r32 = lane & 31, hi = lane >> 5;
  bf16* V_lds = (bf16*)lds; bf16* K_lds = (bf16*)(lds + 2 * SHM_V);
  float* ws = (float*)(lds + 2 * SHM_V + 2 * SHM_K) + wid * 64; float* li_l = ws; float* al_l = ws + 32;
  const int g = wid >> 1, half = wid & 1, hq = kvh * 4 + g, q0 = qblk * 64, kb = q0 - 128;
  bf16* PROJ = (bf16*)PROJ_;
  bf16* Qrow0 = PROJ + ((long)b * SEQ_ + q0 + 32 * half) * LD + CQ + hq * 128;
  const bf16* Kh = PROJ + (long)b * SEQ_ * LD + CK + kvh * 128; const bf16* Vh = PROJ + (long)b * SEQ_ * LD + CV + kvh * 128;
  float m_reg = sinkp[hq] * 1.4426950408889634f, l_reg = 1.f; f32x16 o[4] = {}; bf16x8 qr[8];
  const bf16* Qw = Qrow0 + (long)r32 * LD + hi * 8;
#pragma unroll
  for (int d0 = 0; d0 < 8; ++d0) qr[d0] = ld8(Qw + d0 * 16);
  const float* tb = tab + hq * SWA_TABN + 64 + 4 * hi - 32 * half - r32;
  const float* tmask = tab + hq * SWA_TABN;
  const int sr = tid >> 4, sc = (tid & 15) * 8, vst0 = v_st(sr, sc), vst1 = v_st(32 + sr, sc);
  const int vb0 = (int)(uintptr_t)V_lds + v_rd_base(lane);
  struct { bf16x8 vs0, vs1, ks0, ks1; } sr_[2];
#define TROW(j) ({ int k_ = kb + 64 * (j); k_ = k_ < 0 ? 0 : (k_ > SEQ_ - 64 ? SEQ_ - 64 : k_); k_; })
#define TBJ(j) (((unsigned)(kb + 64 * (j)) < (unsigned)SEQ_) ? (tb + 64 * (j)) : tmask)
#define SLOAD(i, k0) do { sr_[i].vs0 = ld8(&Vh[(long)((k0) + sr) * LD + sc]); sr_[i].vs1 = ld8(&Vh[(long)((k0) + 32 + sr) * LD + sc]); \
    sr_[i].ks0 = ld8(&Kh[(long)((k0) + sr) * LD + sc]); sr_[i].ks1 = ld8(&Kh[(long)((k0) + 32 + sr) * LD + sc]); } while (0)
#define SWRITE(b_, i) do { *(bf16x8*)((char*)V_lds + (b_) * SHM_V + vst0) = sr_[i].vs0;          \
    *(bf16x8*)((char*)V_lds + (b_) * SHM_V + vst1) = sr_[i].vs1; int kc = sc * 2;               \
    *(bf16x8*)((char*)K_lds + (b_) * SHM_K + KSWZ(sr, kc)) = sr_[i].ks0;                       \
    *(bf16x8*)((char*)K_lds + (b_) * SHM_K + KSWZ(32 + sr, kc)) = sr_[i].ks1; } while (0)
#define SWAIT() asm volatile("s_waitcnt vmcnt(4)" ::: "memory")
#define RESC(a) do { if (__any((a) < 1.f)) { if (hi == 0) al_l[r32] = (a); asm volatile("s_waitcnt lgkmcnt(0)" ::: "memory"); \
    for (int d = 0; d < 4; ++d) for (int r = 0; r < 16; ++r) o[d][r] *= al_l[crow(r, hi)]; } } while (0)
  f32x16 pA0, pA1, pB0, pB1; float mnA, mnB, alA, alB; bf16x8 pa0, pa1, pa2, pa3;
  constexpr int SE = 0, SO = 1;
  SLOAD(SE, TROW(0)); asm volatile("s_waitcnt vmcnt(0)" ::: "memory"); SWRITE(0, SE); __syncthreads();
  qkt(pA0, pA1, K_lds, qr, r32, hi); partialSM_b(pA0, pA1, TBJ(0), m_reg, mnA, alA);
  SLOAD(SO, TROW(1)); SLOAD(SE, TROW(2));
  SWAIT(); SWRITE(1, SO); __syncthreads();
#pragma unroll
  for (int j = 1; j < 4; j += 2) {
    SBAR(); qkt(pB0, pB1, (bf16*)((char*)K_lds + SHM_K), qr, r32, hi);
    finishSM(pA0, pA1, alA, l_reg, pa0, pa1, pa2, pa3); SBAR();
    if (j + 2 < 5) SLOAD(SO, TROW(j + 2)); SBAR();
    pv_d0(o, vb0, pa0, pa1, pa2, pa3); partialSM_b(pB0, pB1, TBJ(j), m_reg, mnB, alB);
    __syncthreads(); SWAIT(); SWRITE(0, SE);
    RESC(alB); __syncthreads();
    SBAR(); qkt(pA0, pA1, K_lds, qr, r32, hi);
    finishSM(pB0, pB1, alB, l_reg, pa0, pa1, pa2, pa3); SBAR();
    if (j + 3 < 5) SLOAD(SE, TROW(j + 3)); SBAR();
    pv_d0(o, vb0 + (int)SHM_V, pa0, pa1, pa2, pa3); partialSM_b(pA0, pA1, TBJ(j + 1), m_reg, mnA, alA);
    if (j + 2 < 5) { __syncthreads(); SWAIT(); SWRITE(1, SO); RESC(alA); __syncthreads(); } else { RESC(alA); }
  }
  finishSM(pA0, pA1, alA, l_reg, pa0, pa1, pa2, pa3); SBAR();
  pv_d0(o, vb0, pa0, pa1, pa2, pa3);
  if (hi == 0) li_l[r32] = l_reg; asm volatile("s_waitcnt lgkmcnt(0)" ::: "memory");
  float rli[16];
#pragma unroll
  for (int r = 0; r < 16; ++r) rli[r] = __builtin_amdgcn_rcpf(li_l[crow(r, hi)]);
  unsigned short* Ow = Obase + ((long)b * SEQ_ + q0 + 32 * half) * ldo + hq * 128;
#pragma unroll
  for (int r = 0; r < 16; ++r) { int orow = crow(r, hi);
    for (int d0 = 0; d0 < 4; ++d0) { const unsigned pk = cvtpk(o[d0][r] * rli[r], 0.f); Ow[(long)orow * ldo + d0 * 32 + r32] = (unsigned short)(pk & 0xffffu); } }
  __syncthreads();
#undef TROW
#undef TBJ
#undef SLOAD
#undef SWRITE
#undef SWAIT
#undef RESC
}

__device__ __forceinline__ bf16x8 scale8(bf16x8 v, float w) {
  const u32x4 u = __builtin_bit_cast(u32x4, v); u32x4 o;
  o.x = cvtpk(__uint_as_float(u.x << 16) * w, __uint_as_float(u.x & 0xffff0000u) * w); o.y = cvtpk(__uint_as_float(u.y << 16) * w, __uint_as_float(u.y & 0xffff0000u) * w);
  o.z = cvtpk(__uint_as_float(u.z << 16) * w, __uint_as_float(u.z & 0xffff0000u) * w); o.w = cvtpk(__uint_as_float(u.w << 16) * w, __uint_as_float(u.w & 0xffff0000u) * w);
  return __builtin_bit_cast(bf16x8, o);
}
#define PKF(L, H) (bf16x8){L[0], L[1], L[2], L[3], H[0], H[1], H[2], H[3]}
template <int JH, int KS> __device__ __forceinline__ void ret_u_step(f32x16* aF, f32x16* aB, int vbV, int vbKf, int vbKb) {
  const s16x4 bl = tr_read<JH * 32768 + KS * 4096>(vbV), bh = tr_read<JH * 32768 + KS * 4096 + 2048>(vbV);
  const s16x4 f0l = tr_read<JH * 16384 + 0 * 512 + KS * 4096>(vbKf), f0h = tr_read<JH * 16384 + 0 * 512 + KS * 4096 + 2048>(vbKf);
  const s16x4 f1l = tr_read<JH * 16384 + 1 * 512 + KS * 4096>(vbKf), f1h = tr_read<JH * 16384 + 1 * 512 + KS * 4096 + 2048>(vbKf);
  const s16x4 f2l = tr_read<JH * 16384 + 2 * 512 + KS * 4096>(vbKf), f2h = tr_read<JH * 16384 + 2 * 512 + KS * 4096 + 2048>(vbKf);
  const s16x4 f3l = tr_read<JH * 16384 + 3 * 512 + KS * 4096>(vbKf), f3h = tr_read<JH * 16384 + 3 * 512 + KS * 4096 + 2048>(vbKf);
  const s16x4 g0l = tr_read<JH * 16384 + 0 * 512 + KS * 4096>(vbKb), g0h = tr_read<JH * 16384 + 0 * 512 + KS * 4096 + 2048>(vbKb);
  const s16x4 g1l = tr_read<JH * 16384 + 1 * 512 + KS * 4096>(vbKb), g1h = tr_read<JH * 16384 + 1 * 512 + KS * 4096 + 2048>(vbKb);
  const s16x4 g2l = tr_read<JH * 16384 + 2 * 512 + KS * 4096>(vbKb), g2h = tr_read<JH * 16384 + 2 * 512 + KS * 4096 + 2048>(vbKb);
  const s16x4 g3l = tr_read<JH * 16384 + 3 * 512 + KS * 4096>(vbKb), g3h = tr_read<JH * 16384 + 3 * 512 + KS * 4096 + 2048>(vbKb);
  asm volatile("s_waitcnt lgkmcnt(0)" ::: "memory"); SBAR();
  const bf16x8 B = PKF(bl, bh);
  aF[0] = __builtin_amdgcn_mfma_f32_32x32x16_bf16(PKF(f0l, f0h), B, aF[0], 0, 0, 0); aF[1] = __builtin_amdgcn_mfma_f32_32x32x16_bf16(PKF(f1l, f1h), B, aF[1], 0, 0, 0);
  aF[2] = __builtin_amdgcn_mfma_f32_32x32x16_bf16(PKF(f2l, f2h), B, aF[2], 0, 0, 0); aF[3] = __builtin_amdgcn_mfma_f32_32x32x16_bf16(PKF(f3l, f3h), B, aF[3], 0, 0, 0);
  aB[0] = __builtin_amdgcn_mfma_f32_32x32x16_bf16(PKF(g0l, g0h), B, aB[0], 0, 0, 0); aB[1] = __builtin_amdgcn_mfma_f32_32x32x16_bf16(PKF(g1l, g1h), B, aB[1], 0, 0, 0);
  aB[2] = __builtin_amdgcn_mfma_f32_32x32x16_bf16(PKF(g2l, g2h), B, aB[2], 0, 0, 0); aB[3] = __builtin_amdgcn_mfma_f32_32x32x16_bf16(PKF(g3l, g3h), B, aB[3], 0, 0, 0);
}
template <int LD, int CK, int CV>
__device__ __forceinline__ void ret_u_unit(const unsigned short* PROJ_, unsigned short* UF, unsigned short* UB, long row0, int h, float lf2, float lb2, char* lds, const int wave_s) {
  int tid_ = wave_s * 64 + lane_id_v();
  const int tid = tid_, wid = wave_s, lane = tid & 63, r32 = lane & 31, hi = lane >> 5;
  const bf16* PROJ = (const bf16*)PROJ_;
  char* Vimg = lds; char* Kf = lds + 65536; char* Kb = lds + 98304;
  const int sr = tid >> 4, sc = (tid & 15) * 8, vst0 = v_st(sr, sc), vst1 = v_st(32 + sr, sc);
  const bf16* Kg = PROJ + row0 * LD + CK + h * 128 + sc; const bf16* Vg = PROJ + row0 * LD + CV + h * 256 + sc;
  __syncthreads();
#pragma unroll
  for (int jh = 0; jh < 2; ++jh)
#pragma unroll
    for (int q = 0; q < 2; ++q) { const int j = 64 * jh + 32 * q + sr, vst = q ? vst1 : vst0;
      const bf16x8 k8 = ld8(Kg + (long)j * LD), v0 = ld8(Vg + (long)j * LD), v1 = ld8(Vg + (long)j * LD + 128);
      const float wf = __builtin_amdgcn_exp2f((float)(127 - j) * lf2), wb = __builtin_amdgcn_exp2f((float)j * lb2);
      *(bf16x8*)(Kf + jh * 16384 + vst) = scale8(k8, wf); *(bf16x8*)(Kb + jh * 16384 + vst) = scale8(k8, wb);
      *(bf16x8*)(Vimg + (jh * 2 + 0) * 16384 + vst) = v0; *(bf16x8*)(Vimg + (jh * 2 + 1) * 16384 + vst) = v1; }
  __syncthreads();
  const int vbV = (int)(uintptr_t)Vimg + (wid >> 2) * 16384 + v_rd_base(lane) + (wid & 3) * 512;
  const int vbKf = (int)(uintptr_t)Kf + v_rd_base(lane), vbKb = (int)(uintptr_t)Kb + v_rd_base(lane);
  f32x16 aF[4] = {}, aB[4] = {};
  ret_u_step<0, 0>(aF, aB, vbV, vbKf, vbKb); ret_u_step<0, 1>(aF, aB, vbV, vbKf, vbKb); ret_u_step<0, 2>(aF, aB, vbV, vbKf, vbKb); ret_u_step<0, 3>(aF, aB, vbV, vbKf, vbKb);
  ret_u_step<1, 0>(aF, aB, vbV, vbKf, vbKb); ret_u_step<1, 1>(aF, aB, vbV, vbKf, vbKb); ret_u_step<1, 2>(aF, aB, vbV, vbKf, vbKb); ret_u_step<1, 3>(aF, aB, vbV, vbKf, vbKb);
  __syncthreads();
  char* stg = lds + wid * 8704;
#pragma unroll
  for (int dir = 0; dir < 2; ++dir) { unsigned short* U = dir ? UB : UF;
#pragma unroll
    for (int c = 0; c < 4; ++c)
#pragma unroll
      for (int rq = 0; rq < 4; ++rq) { const f32x16& v = dir ? aB[c] : aF[c];
        *(unsigned long long*)(stg + r32 * 272 + (32 * c + 8 * rq + 4 * hi) * 2) = (unsigned long long)cvtpk_m(v[4 * rq], v[4 * rq + 1]) | ((unsigned long long)cvtpk_m(v[4 * rq + 2], v[4 * rq + 3]) << 32); }
#pragma unroll
    for (int i = 0; i < 8; ++i) { const int ch_ = i * 64 + lane, row = ch_ >> 4, ch = ch_ & 15;
      const u32x4 w = *(const u32x4*)(stg + row * 272 + ch * 16); *(u32x4*)(U + (long)(32 * wid + row) * 128 + ch * 8) = w; } }
}
template <int T> __device__ __forceinline__ void ret_o_pv(f32x16* acc, int vbV, bf16x8 pa0, bf16x8 pa1, bf16x8 pa2, bf16x8 pa3) {
#define RO_ONE(D0) { \
    const s16x4 l0 = tr_read<T * 32768 + v_rd_off(D0, 0, 0)>(vbV), h0 = tr_read<T * 32768 + v_rd_off(D0, 0, 1)>(vbV), l1 = tr_read<T * 32768 + v_rd_off(D0, 1, 0)>(vbV), h1 = tr_read<T * 32768 + v_rd_off(D0, 1, 1)>(vbV); \
    const s16x4 l2 = tr_read<T * 32768 + v_rd_off(D0, 2, 0)>(vbV), h2 = tr_read<T * 32768 + v_rd_off(D0, 2, 1)>(vbV), l3 = tr_read<T * 32768 + v_rd_off(D0, 3, 0)>(vbV), h3 = tr_read<T * 32768 + v_rd_off(D0, 3, 1)>(vbV); \
    asm volatile("s_waitcnt lgkmcnt(0)" ::: "memory"); SBAR(); \
    acc[D0] = __builtin_amdgcn_mfma_f32_32x32x16_bf16(PKF(l0, h0), pa0, acc[D0], 0, 0, 0); acc[D0] = __builtin_amdgcn_mfma_f32_32x32x16_bf16(PKF(l1, h1), pa1, acc[D0], 0, 0, 0); \
    acc[D0] = __builtin_amdgcn_mfma_f32_32x32x16_bf16(PKF(l2, h2), pa2, acc[D0], 0, 0, 0); acc[D0] = __builtin_amdgcn_mfma_f32_32x32x16_bf16(PKF(l3, h3), pa3, acc[D0], 0, 0, 0); }
  RO_ONE(0) RO_ONE(1) RO_ONE(2) RO_ONE(3)
#undef RO_ONE
}
template <int LD, int CQ, int CK, int CV, int CG>
__device__ __forceinline__ void ret_o_unit(unsigned short* PROJ_, unsigned short* Obase, int ldo, const unsigned short* PF_, const unsigned short* PB_, const float* gn, long row0, int h, float lf2, float lb2, char* lds, const int wave_s) {
  int tid_ = wave_s * 64 + lane_id_v();
  const int tid = tid_, wid = wave_s, lane = tid & 63, r32 = lane & 31, hi = lane >> 5;
  bf16* PROJ = (bf16*)PROJ_; const bf16* PF = (const bf16*)PF_; const bf16* PB = (const bf16*)PB_;
  char* Kimg = lds; char* Vimg = lds + 32768; float* xs = (float*)(lds + 98304);
  const int sr = tid >> 4, sc = (tid & 15) * 8, vst0 = v_st(sr, sc), vst1 = v_st(32 + sr, sc);
  const int rb = wid & 3, eh = wid >> 2, rr = 32 * rb + r32;
  const bf16* Kg = PROJ + row0 * LD + CK + h * 128 + sc; const bf16* Vg = PROJ + row0 * LD + CV + h * 256 + sc;
  bf16x8 qr[8], st[16], kv[12];
  { const bf16* Qw = PROJ + (row0 + rr) * LD + CQ + h * 128 + hi * 8;
#pragma unroll
    for (int d0 = 0; d0 < 8; ++d0) qr[d0] = ld8(Qw + d0 * 16); }
#pragma unroll
  for (int et = 0; et < 4; ++et)
#pragma unroll
    for (int q = 0; q < 2; ++q) { const long eo = (long)(64 * et + 32 * q + sr) * 128 + sc; st[et * 2 + q] = ld8(PF + eo); st[8 + et * 2 + q] = ld8(PB + eo); }
#pragma unroll
  for (int jh = 0; jh < 2; ++jh)
#pragma unroll
    for (int q = 0; q < 2; ++q) { const long j = 64 * jh + 32 * q + sr; kv[(jh * 2 + q) * 3 + 0] = ld8(Kg + j * LD); kv[(jh * 2 + q) * 3 + 1] = ld8(Vg + j * LD); kv[(jh * 2 + q) * 3 + 2] = ld8(Vg + j * LD + 128); }
  __syncthreads();
#pragma unroll
  for (int et = 0; et < 4; ++et)
#pragma unroll
    for (int q = 0; q < 2; ++q) { const int o_ = et * 16384 + KSWZ(32 * q + sr, sc * 2); *(bf16x8*)(lds + o_) = st[et * 2 + q]; *(bf16x8*)(lds + 65536 + o_) = st[8 + et * 2 + q]; }
  __syncthreads();
  f32x16 acc[4] = {};
  { const float wfr = __builtin_amdgcn_exp2f((float)(rr + 1) * lf2), wbr = __builtin_amdgcn_exp2f((float)(128 - rr) * lb2);
#pragma unroll
    for (int s = 0; s < 8; ++s) { const bf16x8 qf = scale8(qr[s], wfr), qb = scale8(qr[s], wbr); const int cb = (s * 16 + hi * 8) * 2;
#pragma unroll
      for (int eb = 0; eb < 4; ++eb) { const int o_ = (2 * eh + (eb >> 1)) * 16384 + KSWZ(32 * (eb & 1) + r32, cb);
        const bf16x8 af = *(const bf16x8*)(lds + o_), ab = *(const bf16x8*)(lds + 65536 + o_);
        acc[eb] = __builtin_amdgcn_mfma_f32_32x32x16_bf16(af, qf, acc[eb], 0, 0, 0); acc[eb] = __builtin_amdgcn_mfma_f32_32x32x16_bf16(ab, qb, acc[eb], 0, 0, 0); } } }
  __syncthreads();
#pragma unroll
  for (int jh = 0; jh < 2; ++jh)
#pragma unroll
    for (int q = 0; q < 2; ++q) { const int jl = 32 * q + sr, vst = q ? vst1 : vst0;
      *(bf16x8*)(Kimg + jh * 16384 + KSWZ(jl, sc * 2)) = kv[(jh * 2 + q) * 3 + 0];
      *(bf16x8*)(Vimg + (jh * 2 + 0) * 16384 + vst) = kv[(jh * 2 + q) * 3 + 1]; *(bf16x8*)(Vimg + (jh * 2 + 1) * 16384 + vst) = kv[(jh * 2 + q) * 3 + 2]; }
  __syncthreads();
  const int vbV = (int)(uintptr_t)Vimg + eh * 16384 + v_rd_base(lane);
#pragma unroll
  for (int t = 0; t < 2; ++t) {
    f32x16 p0, p1; qkt(p0, p1, (const bf16*)(Kimg + t * 16384), qr, r32, hi);
#pragma unroll
    for (int r = 0; r < 16; ++r) { const int j0 = 64 * t + crow(r, hi), d0 = rr - j0, d1 = d0 - 32;
      p0[r] *= __builtin_amdgcn_exp2f((float)d0 * (d0 >= 0 ? lf2 : -lb2)); p1[r] *= __builtin_amdgcn_exp2f((float)d1 * (d1 >= 0 ? lf2 : -lb2)); }
    bf16x8 pa0, pa1, pa2, pa3;
#define PK4(P, BASE, OUT) do { unsigned a0 = cvtpk(P[BASE + 0], P[BASE + 1]), a1 = cvtpk(P[BASE + 2], P[BASE + 3]);   \
    unsigned b0 = cvtpk(P[BASE + 4], P[BASE + 5]), b1 = cvtpk(P[BASE + 6], P[BASE + 7]);                              \
    auto r0 = __builtin_amdgcn_permlane32_swap(a0, b0, false, false); auto r1 = __builtin_amdgcn_permlane32_swap(a1, b1, false, false); \
    u32x4 w = {r0[0], r1[0], r0[1], r1[1]}; OUT = *reinterpret_cast<bf16x8*>(&w); } while (0)
    PK4(p0, 0, pa0); PK4(p0, 8, pa1); PK4(p1, 0, pa2); PK4(p1, 8, pa3);
#undef PK4
    SBAR();
    if (t == 0) ret_o_pv<0>(acc, vbV, pa0, pa1, pa2, pa3); else ret_o_pv<1>(acc, vbV, pa0, pa1, pa2, pa3);
  }
  float ss = 0.f;
#pragma unroll
  for (int eb = 0; eb < 4; ++eb)
#pragma unroll
    for (int r = 0; r < 16; ++r) ss += acc[eb][r] * acc[eb][r];
  { auto sw = __builtin_amdgcn_permlane32_swap(__float_as_uint(ss), __float_as_uint(ss), false, false); ss = __uint_as_float(sw[0]) + __uint_as_float(sw[1]); }
  if (hi == 0) xs[wid * 32 + r32] = ss;
  __syncthreads();
  const float tot = xs[wid * 32 + r32] + xs[(wid ^ 4) * 32 + r32];
  const float rn = 1.0f / sqrtf(tot * (1.0f / 256.0f) + 1e-6f);
  { char* stg = lds + wid * 8704; const long grow0 = row0 + 32 * rb;
#pragma unroll
    for (int half = 0; half < 2; ++half) {
#pragma unroll
      for (int e2 = 0; e2 < 2; ++e2)
#pragma unroll
        for (int rq = 0; rq < 4; ++rq) { const f32x16& v = acc[2 * half + e2];
          *(float4*)(stg + r32 * 272 + (32 * e2 + 8 * rq + 4 * hi) * 4) = make_float4(v[4 * rq] * rn, v[4 * rq + 1] * rn, v[4 * rq + 2] * rn, v[4 * rq + 3] * rn); }
#pragma unroll
      for (int i = 0; i < 8; ++i) { const int ch_ = i * 64 + lane, row = ch_ >> 4, ch = ch_ & 15; const int e = 128 * eh + 64 * half + 4 * ch;
        const float4 y = *(const float4*)(stg + row * 272 + ch * 16);
        const unsigned long long gg = *(const unsigned long long*)(PROJ + (grow0 + row) * LD + CG + h * 256 + e); const float4 gv = *(const float4*)(gn + h * 256 + e);
        const unsigned glo = (unsigned)gg, ghi = (unsigned)(gg >> 32);
        const float y0 = y.x * gv.x * __uint_as_float(glo << 16), y1 = y.y * gv.y * __uint_as_float(glo & 0xffff0000u), y2 = y.z * gv.z * __uint_as_float(ghi << 16), y3 = y.w * gv.w * __uint_as_float(ghi & 0xffff0000u);
        *(unsigned long long*)(Obase + (grow0 + row) * ldo + h * 256 + e) = (unsigned long long)cvtpk(y0, y1) | ((unsigned long long)cvtpk(y2, y3) << 32); } } }
}
#undef PKF
#undef KSWZ
#undef SBAR
}

constexpr int NWAVES = 8;
constexpr int BATCH = 2, SEQ = 8192, DM = 1024, M = BATCH * SEQ, FF = 4096;
constexpr int EVEN_IN = 4608, EVEN_OUT = 2048, ODD_IN = 1536;
constexpr int C_QA = 0, C_KA = 512, C_VA = 1024, C_GA = 2048, C_QB = 3072, C_KB = 4096, C_VB = 4352;
constexpr int C_QC = 0, C_KC = 1024, C_VC = 1280;
constexpr int RCH = 128, NCH = SEQ / RCH;
constexpr float EPS = 1e-6f;
constexpr size_t MiB = 1u << 20;
constexpr size_t WS_CTL = 0, CTL_ZERO_BYTES = 64 * 1024;
constexpr size_t WS_TAB = 1 * MiB;
constexpr size_t WS_WIN0 = 2 * MiB, WS_WOUT0 = 11 * MiB, WS_WUP0 = 15 * MiB, WS_WDN0 = 23 * MiB, WS_WIN1 = 31 * MiB, WS_WOUT1 = 34 * MiB, WS_WUP1 = 36 * MiB, WS_WDN1 = 44 * MiB;
constexpr size_t WS_PART = 52 * MiB;
constexpr size_t WS_XN = 56 * MiB;
constexpr size_t WS_PROJ = 88 * MiB;
constexpr size_t WS_H = WS_PROJ, WS_PROJ1 = WS_PROJ, WS_O1 = WS_PROJ + 48 * MiB;
constexpr size_t WS_Q8 = WS_PROJ + 144 * MiB, WS_K8 = WS_Q8 + 16 * MiB;
constexpr size_t WS_V8T = WS_K8 + 4 * MiB;
constexpr size_t WS_END = WS_V8T + 4 * MiB;
static_assert(WS_END <= 256 * MiB, "ws map");
constexpr int CW_BAR = 1024;
constexpr int RING_OFF = 0, RING_BYTES = 131072;
constexpr int LDSCTL_OFF = RING_BYTES, MISC_OFF = LDSCTL_OFF + 320;
constexpr int XS_OFF = RING_BYTES + 1024;
constexpr int SB_OFF = XS_OFF + 4096;
constexpr int LDS_BYTES = 147456;
static_assert(MISC_OFF + 128 <= LDS_BYTES, "LDS map");

#define GAS __attribute__((address_space(1)))
#define LAS __attribute__((address_space(3)))
typedef unsigned short bf16;
typedef unsigned v4u __attribute__((ext_vector_type(4)));
typedef float f32x4 __attribute__((ext_vector_type(4)));
typedef GAS unsigned gu32;
#define RLX_AGENT __ATOMIC_RELAXED, __HIP_MEMORY_SCOPE_AGENT
#define LDS_WAIT() asm volatile("s_waitcnt lgkmcnt(0)" ::: "memory")
#define VM_WAIT() asm volatile("s_waitcnt vmcnt(0)" ::: "memory")
__device__ __forceinline__ unsigned f2bf(float f) { unsigned u = __builtin_bit_cast(unsigned, f); return (u + 0x7fffu + ((u >> 16) & 1u)) >> 16; }
__device__ __forceinline__ unsigned pk2(float lo, float hi) { return f2bf(lo) | (f2bf(hi) << 16); }
__device__ __forceinline__ float bf2f(unsigned u) { return __uint_as_float(u << 16); }
#define XB_TMO      128
#define XB_XCNT(j)  (256  + 64 * (j))
#define XB_XSUB(j)  (1280 + 64 * (j))
#define XB_XGEN(j)  (2304 + 64 * (j))
#define XB_TOP      3328
#define XB_TOPGEN   3392
#define XCD_BAR_WORDS 3456
#define XB_SPIN_CAP (1u << 18)

__device__ __forceinline__ unsigned xb_ld(unsigned* p)              { return __hip_atomic_load(p, __ATOMIC_RELAXED, __HIP_MEMORY_SCOPE_AGENT); }
__device__ __forceinline__ unsigned xb_add(unsigned* p, unsigned v) { return __hip_atomic_fetch_add(p, v, __ATOMIC_RELAXED, __HIP_MEMORY_SCOPE_AGENT); }
__device__ __forceinline__ unsigned xb_xcc_id() { return (unsigned)__builtin_amdgcn_s_getreg((3 << 11) | 20) & 0xFu; }
#define XB_SPIN(cond, bar) do { unsigned _sp = 0; while (cond) { __builtin_amdgcn_s_sleep(1); \
    if ((++_sp & 255u) == 0u) { if (xb_ld(&(bar)[XB_TMO])) break; if (_sp > XB_SPIN_CAP) { atomicAdd(&(bar)[XB_TMO], 1u); break; } } } } while (0)

struct XcdBarrier {
    int wave; unsigned* bar; unsigned x;
    volatile LAS unsigned* st;
};

__device__ __forceinline__ XcdBarrier xcd_barrier_post(unsigned* bar, volatile LAS unsigned* st, int wave) {
    XcdBarrier b; b.bar = bar; b.x = xb_xcc_id(); b.st = st; b.wave = wave;
    if (is_t0(wave)) (void)xb_add(&bar[XB_XCNT(b.x)], 1u);
    return b;
}
__device__ __forceinline__ void xcd_barrier_complete(unsigned* bar, unsigned x, unsigned& nloc, unsigned& nx) {
    const unsigned G = gridDim.x * gridDim.y * gridDim.z;
    unsigned sum, cnt, mine, sp = 0u;
    for (;;) {
        sum = 0u; cnt = 0u; mine = 0u;
#pragma unroll
        for (unsigned j = 0; j < 16; ++j) { const unsigned c = xb_ld(&bar[XB_XCNT(j)]); sum += c; cnt += (c > 0u) ? 1u : 0u; mine = (j == x) ? c : mine; }
        if (sum == G) break;
        __builtin_amdgcn_s_sleep(1);
        if ((++sp & 255u) == 0u) { if (xb_ld(&bar[XB_TMO])) break; if (sp > XB_SPIN_CAP) { atomicAdd(&bar[XB_TMO], 1u); break; } }
    }
    nloc = mine > 0u ? mine : 1u; nx = cnt > 0u ? cnt : 1u;
}

__device__ __forceinline__ void xcd_barrier(const XcdBarrier& b) {
    asm volatile("s_waitcnt vmcnt(0)" ::: "memory");
    __syncthreads();
    if (is_t0(b.wave)) {
        unsigned* bar = b.bar;
        __builtin_amdgcn_s_waitcnt(0);
        unsigned nloc = b.st[0], nx = b.st[1];
        if (nloc == 0u) { xcd_barrier_complete(bar, b.x, nloc, nx); b.st[0] = nloc; b.st[1] = nx; }
        const unsigned old = xb_add(&bar[XB_XSUB(b.x)], 1u);
        const unsigned gen = old / nloc;
        if (old + 1u == (gen + 1u) * nloc) {
            __builtin_amdgcn_fence(__ATOMIC_RELEASE, "agent");
            asm volatile("s_waitcnt vmcnt(0)" ::: "memory");
            const unsigned og = xb_add(&bar[XB_TOP], 1u);
            const unsigned tg = og / nx;
            if (og + 1u == (tg + 1u) * nx) xb_add(&bar[XB_TOPGEN], 1u);
            else XB_SPIN(xb_ld(&bar[XB_TOPGEN]) == tg, bar);
            __builtin_amdgcn_fence(__ATOMIC_ACQUIRE, "agent");
            xb_add(&bar[XB_XGEN(b.x)], 1u);
            asm volatile("s_waitcnt vmcnt(0)" ::: "memory");
        } else {
            XB_SPIN(xb_ld(&bar[XB_XGEN(b.x)]) == gen, bar);
            __builtin_amdgcn_fence(__ATOMIC_ACQUIRE, "agent");
            asm volatile("s_waitcnt vmcnt(0)" ::: "memory");
        }
    }
    __syncthreads();
}

struct Frame {
    LAS unsigned char* lds;
    volatile LAS unsigned* MISC;
    gu32* ctl;
    int wave;
    int vcu, G;
};
__device__ __forceinline__ float wave_sum(float v) {
#pragma unroll
    for (int o = 1; o < 64; o <<= 1) v += __shfl_xor(v, o);
    return v;
}
__device__ __forceinline__ float wave_max(float v) {
#pragma unroll
    for (int o = 1; o < 64; o <<= 1) v = fmaxf(v, __shfl_xor(v, o));
    return v;
}
__device__ __forceinline__ int perm_col(int n0, int pmode) {
    const int r = n0 & 255, b = n0 & ~255;
    if (pmode == 1) return b + 128 * ((r >> 6) & 1) + 64 * (r >> 7) + (r & 32);
    if (pmode == 2) return b + 128 * ((r >> 5) & 1) + 64 * (r >> 7) + 32 * ((r >> 6) & 1);
    return n0;
}
__device__ __forceinline__ void p0_transpose_item(const float* W, int K, int N, bf16* WT, LAS float* scr, int item, int lane, int pmode = 0, int plo = 0, int phi = 0, int plo2 = 0, int phi2 = 0) {
    const int nblk = N / 32, kb = item / nblk, nb = item % nblk, k0 = 64 * kb, n0 = 32 * nb;
    const int r0 = ((n0 >= plo && n0 < phi) || (n0 >= plo2 && n0 < phi2)) ? perm_col(n0, pmode) : n0;
#pragma unroll 8
    for (int i = 0; i < 32; ++i) { const int kk = 2 * i + (lane >> 5); scr[kk * 33 + (lane & 31)] = W[(size_t)(k0 + kk) * N + n0 + (lane & 31)]; }
    LDS_WAIT(); asm volatile("" ::: "memory");
    const int c = lane & 7;
#pragma unroll
    for (int j = 0; j < 4; ++j) { const int n = (lane >> 3) + 8 * j; const LAS float* s = scr + (8 * c) * 33 + n;
        v4u o; o.x = pk2(s[0 * 33], s[1 * 33]); o.y = pk2(s[2 * 33], s[3 * 33]); o.z = pk2(s[4 * 33], s[5 * 33]); o.w = pk2(s[6 * 33], s[7 * 33]);
        *(GAS v4u*)(WT + (size_t)(r0 + n) * K + k0 + 8 * c) = o; }
    LDS_WAIT(); asm volatile("" ::: "memory");
}
__device__ __forceinline__ void rms_row_to_bf16(int lane, const float* xrow, const float* g, bf16* orow) {
    const GAS f32x4* xr = (const GAS f32x4*)xrow + lane; const GAS f32x4* gr = (const GAS f32x4*)g + lane;
    f32x4 v[4]; float s = 0.f;
#pragma unroll
    for (int j = 0; j < 4; ++j) { v[j] = xr[64 * j]; s += (v[j].x * v[j].x + v[j].y * v[j].y) + (v[j].z * v[j].z + v[j].w * v[j].w); }
    const float rstd = 1.f / sqrtf(wave_sum(s) * (1.f / DM) + EPS);
    GAS unsigned long long* o8 = (GAS unsigned long long*)orow + lane;
#pragma unroll
    for (int j = 0; j < 4; ++j) { const f32x4 gg = gr[64 * j];
        o8[64 * j] = (unsigned long long)pk2(v[j].x * rstd * gg.x, v[j].y * rstd * gg.y) | ((unsigned long long)pk2(v[j].z * rstd * gg.z, v[j].w * rstd * gg.w) << 32); }
}
__device__ __forceinline__ int t5_bucket(int rel) {
    const int n = rel < 0 ? -rel : rel; int v;
    if (n < 8) v = n; else { int l = 2 + (31 - __builtin_clz((unsigned)(n * n))); v = l < 15 ? l : 15; }
    return (rel > 0 ? 16 : 0) + v;
}
__device__ __forceinline__ float log_sigmoid(float x) { return -log1pf(__expf(-x)); }

struct Ptrs {
    const float* in[17]; float* out; unsigned char* ws;
};

constexpr int I_IN0 = (DM / 64) * (EVEN_IN / 32), I_OUT0 = (EVEN_OUT / 64) * (DM / 32), I_UP = (DM / 64) * (FF / 32), I_DN = (FF / 64) * (DM / 32), I_IN1 = (DM / 64) * (ODD_IN / 32), I_OUT1 = (DM / 64) * (DM / 32);
template <int SET> __device__ __forceinline__ void convert_weights(Frame& F, const Ptrs& P, int gw, int ngw) {
    const int lane = lane_id_v();
    LAS float* scr = (LAS float*)(F.lds + RING_OFF + F.wave * 16384);
    unsigned char* ws = P.ws;
    constexpr int NIT = SET == 0 ? I_IN0 : SET == 1 ? I_OUT0 + I_UP + I_DN + I_IN1 : I_OUT1 + I_UP + I_DN;
    for (int it = gw; it < NIT; it += ngw) {
        int r = it;
        if (SET == 0) {
            p0_transpose_item(P.in[3], DM, EVEN_IN, (bf16*)(ws + WS_WIN0), scr, r, lane, 1, C_QA, C_VA, C_QB, C_VB);
        } else if (SET == 1) {
            if (r < I_OUT0) { p0_transpose_item(P.in[4], EVEN_OUT, DM, (bf16*)(ws + WS_WOUT0), scr, r, lane); continue; } r -= I_OUT0;
            if (r < I_UP) { p0_transpose_item(P.in[15], DM, FF, (bf16*)(ws + WS_WUP0), scr, r, lane); continue; } r -= I_UP;
            if (r < I_DN) { p0_transpose_item(P.in[16], FF, DM, (bf16*)(ws + WS_WDN0), scr, r, lane); continue; } r -= I_DN;
            p0_transpose_item(P.in[11], DM, ODD_IN, (bf16*)(ws + WS_WIN1), scr, r, lane, 2, C_QC, C_VC);
        } else {
            if (r < I_OUT1) { p0_transpose_item(P.in[12], DM, DM, (bf16*)(ws + WS_WOUT1), scr, r, lane); continue; } r -= I_OUT1;
            if (r < I_UP) { p0_transpose_item(P.in[15] + (size_t)DM * FF, DM, FF, (bf16*)(ws + WS_WUP1), scr, r, lane); continue; } r -= I_UP;
            p0_transpose_item(P.in[16] + (size_t)DM * FF, FF, DM, (bf16*)(ws + WS_WDN1), scr, r, lane);
        }
    }
}
template <int SET> __device__ __forceinline__ void idle_filler(Frame& F, const Ptrs& P, int nwg) {
    const int G = F.G, c = (int)blockIdx.x, rem = nwg % G;
    if (rem == 0) { convert_weights<SET>(F, P, c * NWAVES + F.wave, G * NWAVES); return; }
    if (c >= rem) convert_weights<SET>(F, P, (c - rem) * NWAVES + F.wave, (G - rem) * NWAVES);
}
__device__ __forceinline__ void p0_prologue(Frame& F, const Ptrs& P) {
    const int lane = lane_id_v(), tid = F.wave * 64 + lane;
    const int gw = F.vcu * NWAVES + F.wave, NGW = F.G * NWAVES;
    convert_weights<0>(F, P, gw, NGW);
    for (int m = gw; m < M; m += NGW) rms_row_to_bf16(lane, P.in[0] + (size_t)m * DM, P.in[1], (bf16*)(P.ws + WS_XN) + (size_t)m * DM);
}

constexpr int SWA_TAB_OFF = 69632;
__device__ __forceinline__ void swa_phase(Frame& F, const Ptrs& P, unsigned char* ldsg, bool dummy, int i_lo, int i_hi) {
    const int lane = lane_id_v(), tid = F.wave * 64 + lane;
    float* tab = (float*)(ldsg + SWA_TAB_OFF);
    for (int i = tid; i < 8 * adense::SWA_TABN; i += NWAVES * 64) { const int h = i / adense::SWA_TABN, rel = i % adense::SWA_TABN - 192, n = rel < 0 ? -rel : rel;
        tab[i] = (n <= 128) ? P.in[10][t5_bucket(rel) * 8 + h] * 1.4426950408889634f : -1e30f; }
    __syncthreads();
    const int UPW = (512 + F.G - 1) / F.G;
    for (int i = i_lo; i < i_hi && i < UPW; ++i) { const int u = F.vcu * UPW + i; if (u >= 512) break;
        const int bk = u >> 7, qblk = u & 127;
        adense::swa_unit<EVEN_IN, C_QB, C_KB, C_VB, SEQ>((unsigned short*)(P.ws + WS_PROJ), dummy ? (unsigned short*)(P.ws + WS_XN) : (unsigned short*)(P.ws + WS_PROJ) + C_QB, dummy ? DM : EVEN_IN, bk >> 1, bk & 1, qblk, P.in[9], tab, (char*)ldsg, F.wave); }
}
__device__ __forceinline__ void ret_u_phase(Frame& F, const Ptrs& P, unsigned char* ldsg) {
    bf16* Ust = (bf16*)P.out;
    for (int u = F.vcu; u < BATCH * 4 * NCH; u += F.G) {
        const int n = u & (NCH - 1), h = (u >> 6) & 3, b = u >> 8;
        const float lf2 = log_sigmoid(P.in[5][h]) * 1.4426950408889634f, lb2 = log_sigmoid(P.in[5][4 + h]) * 1.4426950408889634f;
        bf16* UF = Ust + ((size_t)((0 * 2 + b) * 4 + h) * NCH + n) * 32768; bf16* UB = Ust + ((size_t)((1 * 2 + b) * 4 + h) * NCH + n) * 32768;
        adense::ret_u_unit<EVEN_IN, C_KA, C_VA>((const unsigned short*)(P.ws + WS_PROJ), UF, UB, (long)b * SEQ + (long)n * RCH, h, lf2, lb2, (char*)ldsg, F.wave);
    }
    __syncthreads();
}
__device__ __forceinline__ void ret_scan_phase(Frame& F, const Ptrs& P) {
    const int lane = lane_id_v(), tid = F.wave * 64 + lane;
    bf16* Ust = (bf16*)P.out;
    for (int idx = F.vcu * 512 + tid; idx < 2 * 8 * 8192; idx += F.G * 512) {
        const int dir = idx >> 16, rem = idx & 65535, bh = rem >> 13, el = (rem & 8191) * 4, h = bh & 3;
        const float decay = __expf(128.f * log_sigmoid(P.in[5][dir * 4 + h]));
        unsigned long long* p = (unsigned long long*)(Ust + ((size_t)(dir * 8 + bh) * NCH + (dir ? NCH - 1 : 0)) * 32768 + el);
        const long step = dir ? -8192 : 8192;
        float s0 = 0.f, s1 = 0.f, s2 = 0.f, s3 = 0.f;
        for (int nn = 0; nn < NCH; nn += 8) {
            unsigned long long uu[8];
#pragma unroll
            for (int k = 0; k < 8; ++k) uu[k] = p[k * step];
#pragma unroll
            for (int k = 0; k < 8; ++k) { p[k * step] = (unsigned long long)pk2(s0, s1) | ((unsigned long long)pk2(s2, s3) << 32);
                const unsigned lo = (unsigned)uu[k], hi = (unsigned)(uu[k] >> 32);
                s0 = decay * s0 + __uint_as_float(lo << 16); s1 = decay * s1 + __uint_as_float(lo & 0xffff0000u); s2 = decay * s2 + __uint_as_float(hi << 16); s3 = decay * s3 + __uint_as_float(hi & 0xffff0000u); }
            p += 8 * step;
        }
    }
}
__device__ __forceinline__ void ret_o_phase(Frame& F, const Ptrs& P, unsigned char* ldsg, bool dummy) {
    const bf16* Ust = (const bf16*)P.out;
    for (int u = F.vcu; u < BATCH * 4 * NCH; u += F.G) {
        const int n = u & (NCH - 1), h = (u >> 6) & 3, b = u >> 8;
        const float lf2 = log_sigmoid(P.in[5][h]) * 1.4426950408889634f, lb2 = log_sigmoid(P.in[5][4 + h]) * 1.4426950408889634f;
        const bf16* PF = Ust + ((size_t)((0 * 2 + b) * 4 + h) * NCH + n) * 32768; const bf16* PB = Ust + ((size_t)((1 * 2 + b) * 4 + h) * NCH + n) * 32768;
        adense::ret_o_unit<EVEN_IN, C_QA, C_KA, C_VA, C_GA>((unsigned short*)(P.ws + WS_PROJ), dummy ? (unsigned short*)(P.ws + WS_XN) : (unsigned short*)(P.ws + WS_PROJ) + C_GA, dummy ? DM : EVEN_IN, PF, PB, P.in[6], (long)b * SEQ + (long)n * RCH, h, lf2, lb2, (char*)ldsg, F.wave);
    }
    __syncthreads();
}

__device__ unsigned g_bar_state[XCD_BAR_WORDS + 64];
struct Args { Ptrs p; int ph_lo, ph_hi; };
__global__ void __launch_bounds__(NWAVES * 64, 2) mega_fwd(Args args) {
    extern __shared__ __attribute__((aligned(16))) unsigned char lds[];
    Frame F;
    F.lds = (LAS unsigned char*)lds;
    F.MISC = (volatile LAS unsigned*)(F.lds + MISC_OFF);
    F.wave = __builtin_amdgcn_readfirstlane((int)threadIdx.x >> 6);
    F.G = gridDim.x; { const int bx = blockIdx.x; F.vcu = (F.G % 8 == 0) ? (bx % 8) * (F.G / 8) + bx / 8 : bx; }
    const Ptrs& P = args.p;
    unsigned char* ws = P.ws;
    F.ctl = (gu32*)(ws + WS_CTL);
    for (int u = F.wave * 64 + lane_id_v(); u < (LDS_BYTES - LDSCTL_OFF) / 4; u += NWAVES * 64) ((LAS unsigned*)(F.lds + LDSCTL_OFF))[u] = 0u;
    __syncthreads();
    XcdBarrier bar = xcd_barrier_post(g_bar_state, F.MISC + 8, F.wave);
#define GRID_BAR() xcd_barrier(bar)
    bf16* XN = (bf16*)(ws + WS_XN); bf16* PROJ = (bf16*)(ws + WS_PROJ); bf16* HB = (bf16*)(ws + WS_H); bf16* PROJ1 = (bf16*)(ws + WS_PROJ1); bf16* O1 = (bf16*)(ws + WS_O1);
    float* PART0 = (float*)(ws + WS_PART); float* PART1 = PART0 + (size_t)M * 16; float* PART2 = PART1 + (size_t)M * 16;
    const float* x = P.in[0];

    p0_prologue(F, P);
    GRID_BAR();
    { pg8::Gemm g{XN, (const bf16*)(ws + WS_WIN0), M, EVEN_IN, DM, DM}; pg8::StaticOrder S; S.init(M, EVEN_IN, F.G, (int)blockIdx.x);
      pg8::EpiProj E{PROJ, EVEN_IN, nullptr, (LAS float*)(F.lds + XS_OFF), 0, P.in[7], P.in[8], nullptr, nullptr, nullptr};
      pg8::gemm_phase<pg8::EpiProj, pg8::StaticOrder, true, true>(F.lds + RING_OFF, g, S, E, F.wave); }
    idle_filler<1>(F, P, (M / 256) * (EVEN_IN / 256)); GRID_BAR();
    { const int swa_half = (512 + F.G - 1) / F.G / 2;
#pragma nounroll
      for (int st = 0; st < 2; ++st) { if ((st == 0) == ((F.vcu & 1) != 0)) swa_phase(F, P, lds, false, 0, swa_half); else ret_u_phase(F, P, lds); } }
    GRID_BAR();
    ret_scan_phase(F, P); GRID_BAR();
    { const int swa_half = (512 + F.G - 1) / F.G / 2;
#pragma nounroll
      for (int st = 0; st < 2; ++st) { if ((st == 0) == ((F.vcu & 1) != 0)) ret_o_phase(F, P, lds, false); else swa_phase(F, P, lds, false, swa_half, 1 << 20); } }
    GRID_BAR();
    { pg8::Gemm g{PROJ + C_GA, (const bf16*)(ws + WS_WOUT0), M, DM, EVEN_OUT, EVEN_IN}; pg8::StaticOrder S; S.init(M, DM, F.G, (int)blockIdx.x);
      pg8::EpiRes<0> E{x, nullptr, nullptr, nullptr, XN, P.in[2], PART0, nullptr};
      pg8::gemm_phase<pg8::EpiRes<0>, pg8::StaticOrder, true, true>(F.lds + RING_OFF, g, S, E, F.wave); GRID_BAR(); }
    { pg8::Gemm g{XN, (const bf16*)(ws + WS_WUP0), M, FF, DM, DM}; pg8::StaticOrder S; S.init(M, FF, F.G, (int)blockIdx.x);
      pg8::EpiBf<2> E{HB, FF, nullptr};
      pg8::gemm_phase<pg8::EpiBf<2>, pg8::StaticOrder, true, true>(F.lds + RING_OFF, g, S, E, F.wave); GRID_BAR(); }
    { pg8::Gemm g{HB, (const bf16*)(ws + WS_WDN0), M, DM, FF, FF}; pg8::StaticOrder S; S.init(M, DM, F.G, (int)blockIdx.x);
      pg8::EpiRes<1> E{nullptr, XN, P.in[2], nullptr, XN, P.in[1] + DM, PART1, PART0};
      pg8::gemm_phase<pg8::EpiRes<1>, pg8::StaticOrder, true, true>(F.lds + RING_OFF, g, S, E, F.wave); GRID_BAR(); }
    { pg8::Gemm g{XN, (const bf16*)(ws + WS_WIN1), M, ODD_IN, DM, DM}; pg8::StaticOrder S; S.init(M, ODD_IN, F.G, (int)blockIdx.x);
      pg8::EpiProj E{PROJ1, ODD_IN, PART1, (LAS float*)(F.lds + XS_OFF), 1, P.in[13], P.in[14], ws + WS_Q8, ws + WS_K8, ws + WS_V8T};
      pg8::gemm_phase<pg8::EpiProj, pg8::StaticOrder, true, true>(F.lds + RING_OFF, g, S, E, F.wave); }
    idle_filler<2>(F, P, (M / 256) * (ODD_IN / 256)); GRID_BAR();
    { const int UPW = (512 + F.G - 1) / F.G;
      volatile LAS float* sbp = (volatile LAS float*)(F.lds + SB_OFF);
      { float mq = 0.f, mk = 0.f; for (int i = 0; i < 128; ++i) { mq = fmaxf(mq, fabsf(P.in[13][i])); mk = fmaxf(mk, fabsf(P.in[14][i])); }
        const float sbound = 128.f * mq * mk * (0.08838834764831845f * 1.4426950408889634f) * 1.02f + 0.5f;
        __syncthreads(); if (F.wave == 0 && lane_id_v() == 0) *sbp = sbound; __syncthreads(); }
      const bool fixed_ref = __builtin_amdgcn_readfirstlane((int)(*sbp < 60.f)) != 0;
#define ATTN_UNITS(...) for (int i = 0; i < UPW; ++i) { const int u = F.vcu * UPW + i; if (u >= 512) break; \
          const int bk = u >> 7, rem = u & 127, gq = rem >> 5, qb = rem & 31, b = bk >> 1, kvh = bk & 1, hq = kvh * 4 + gq; \
          const adense::bf16* Qb = (const adense::bf16*)(PROJ1 + (size_t)(b * SEQ + qb * 256) * ODD_IN + C_QC + hq * 128); \
          const adense::bf16* Kh = (const adense::bf16*)(PROJ1 + (size_t)(b * SEQ) * ODD_IN + C_KC + kvh * 128); \
          const adense::bf16* Vh = (const adense::bf16*)(PROJ1 + (size_t)(b * SEQ) * ODD_IN + C_VC + kvh * 128); \
          unsigned short* Oo = O1 + (size_t)(b * SEQ + qb * 256) * DM + hq * 128; __VA_ARGS__; }
      if (__builtin_expect(fixed_ref, 1)) { ATTN_UNITS(adense::attn_dense_body10_f8<DM, SEQ / 64>(ws + WS_Q8 + (size_t)(b * SEQ + qb * 256) * 1024 + hq * 128, ws + WS_K8 + (size_t)(b * SEQ) * 256 + kvh * 128, ws + WS_V8T + (size_t)(b * 2 + kvh) * 128 * 8192, Oo, (char*)lds + RING_OFF, F.lds + RING_OFF, F.wave)) }
      else { ATTN_UNITS((adense::attn_dense_body3_n<ODD_IN, ODD_IN, DM>(Qb, Kh, Vh, Oo, SEQ, (char*)lds + RING_OFF, F.wave))) }
#undef ATTN_UNITS
      GRID_BAR(); }
    { pg8::Gemm g{O1, (const bf16*)(ws + WS_WOUT1), M, DM, DM, DM}; pg8::StaticOrder S; S.init(M, DM, F.G, (int)blockIdx.x);
      pg8::EpiRes<1> E{nullptr, XN, P.in[1] + DM, nullptr, XN, P.in[2] + DM, PART2, nullptr};
      pg8::gemm_phase<pg8::EpiRes<1>, pg8::StaticOrder, true, true>(F.lds + RING_OFF, g, S, E, F.wave); GRID_BAR(); }
    { pg8::Gemm g{XN, (const bf16*)(ws + WS_WUP1), M, FF, DM, DM}; pg8::StaticOrder S; S.init(M, FF, F.G, (int)blockIdx.x);
      pg8::EpiBf<2> E{HB, FF, nullptr};
      pg8::gemm_phase<pg8::EpiBf<2>, pg8::StaticOrder, true, true>(F.lds + RING_OFF, g, S, E, F.wave); GRID_BAR(); }
    { pg8::Gemm g{HB, (const bf16*)(ws + WS_WDN1), M, DM, FF, FF}; pg8::StaticOrder S; S.init(M, DM, F.G, (int)blockIdx.x);
      pg8::EpiRes<2> E{nullptr, XN, P.in[2] + DM, P.out, nullptr, nullptr, nullptr, PART2};
      pg8::gemm_phase<pg8::EpiRes<2>, pg8::StaticOrder, true, true>(F.lds + RING_OFF, g, S, E, F.wave); }
    { __syncthreads();
      if (is_t0(F.wave)) { const unsigned old_ = xb_add(&g_bar_state[XCD_BAR_WORDS], 1u); F.MISC[12] = (old_ + 1u == (unsigned)F.G) ? 1u : 0u; }
      __syncthreads();
      if (F.MISC[12]) { for (int i = F.wave * 64 + lane_id_v(); i < XCD_BAR_WORDS + 64; i += NWAVES * 64) __hip_atomic_store(&g_bar_state[i], 0u, __ATOMIC_RELAXED, __HIP_MEMORY_SCOPE_AGENT); } }
}

extern "C" void kernel_launch(void* const* d_in, const int* in_sizes, int n_in, void* d_out, int out_size, void* d_ws, size_t ws_size, hipStream_t stream) {
    static int grid = 0;
    if (grid == 0) {
        if (n_in != 17 || in_sizes[0] != M * DM || out_size != M * DM || ws_size < WS_END) { fprintf(stderr, "kernel_launch: shape mismatch (n_in %d, in0 %d, out %d, ws %zu)\n", n_in, n_in > 0 ? in_sizes[0] : -1, out_size, ws_size); grid = -1; return; }
        int dev = 0, cus = 0, per_cu = 0;
        if (hipGetDevice(&dev) != hipSuccess || hipDeviceGetAttribute(&cus, hipDeviceAttributeMultiprocessorCount, dev) != hipSuccess) { grid = -1; return; }
        if (hipFuncSetAttribute((const void*)mega_fwd, hipFuncAttributeMaxDynamicSharedMemorySize, LDS_BYTES) != hipSuccess) { fprintf(stderr, "kernel_launch: hipFuncSetAttribute failed\n"); grid = -1; return; }
        if (hipOccupancyMaxActiveBlocksPerMultiprocessor(&per_cu, (const void*)mega_fwd, NWAVES * 64, LDS_BYTES) != hipSuccess || per_cu < 1) { fprintf(stderr, "kernel_launch: occupancy query reports %d blocks per CU\n", per_cu); (void)hipGetLastError(); grid = -1; return; }
        grid = cus;
    }
    if (grid < 0) return;
    Args a{};
    for (int i = 0; i < 17; ++i) a.p.in[i] = (const float*)d_in[i];
    a.p.out = (float*)d_out; a.p.ws = (unsigned char*)d_ws; a.ph_lo = 0; a.ph_hi = 0;
    hipLaunchKernelGGL(mega_fwd, dim3(grid), dim3(NWAVES * 64), LDS_BYTES, stream, a);
    const hipError_t le = hipPeekAtLastError();
    if (le != hipSuccess) fprintf(stderr, "kernel_launch: launch failed: %s\n", hipGetErrorName(le));
}
```
